# Optimizing an MI355X kernel written in HIP

```python
import math
import jax, jax.numpy as jnp
from jax import lax
import numpy as np

D_MODEL = 1024
BATCH = 8
SEQ = 2048
DEPTH = 2

HEAD_DIM = 64
N_HEADS_A = 4
N_HEADS_B = 6
N_HEADS_C = 6
WIDTH_A = N_HEADS_A * HEAD_DIM
WIDTH_B = N_HEADS_B * HEAD_DIM
WIDTH_C = N_HEADS_C * HEAD_DIM
MIX_WIDTH = WIDTH_A + WIDTH_B + WIDTH_C
DIFF_DIM = HEAD_DIM // 2
ROPE_THETA = 500000.0
ROPE_FRACTION = 4
Q_BLOCK = 128
DILATED_CONFIGS = ((128, 1), (512, 4), (2048, 16))
SW_BLOCK = 64
GRID_W = 64
NA_ROWS_MAX = 8
NA_COLS = 16
D_FF_DENSE = 2816
N_EXPERTS = 8
TOP_K = 2
D_FF_EXPERT = 3584
N_DENSE = (DEPTH + 1) // 2
N_MOE = DEPTH // 2
DEEPNORM_ALPHA = (2 * DEPTH) ** 0.25
DEEPNORM_BETA = (8 * DEPTH) ** -0.25
LN_EPS = 1e-5
NEG = -1e30

kernel_name = 'hybrid_diff_dilated_natten_moe_encoder'


def layer_norm(x, g, b):
    xf = x.astype(jnp.float32)
    mu = jnp.mean(xf, axis=-1, keepdims=True)
    var = jnp.mean(jnp.square(xf - mu), axis=-1, keepdims=True)
    y = (xf - mu) * lax.rsqrt(var + LN_EPS) * g.astype(jnp.float32) + b.astype(jnp.float32)
    return y.astype(x.dtype)


def rms_norm(x, g):
    xf = x.astype(jnp.float32)
    y = xf * lax.rsqrt(jnp.mean(xf * xf, axis=-1, keepdims=True) + LN_EPS) * g.astype(jnp.float32)
    return y.astype(x.dtype)


def rope_tables(seq, rot_dim):
    inv = ROPE_THETA ** (-jnp.arange(0, rot_dim, 2, dtype=jnp.float32) / rot_dim)
    ang = jnp.arange(seq, dtype=jnp.float32)[:, None] * inv[None, :]
    return jnp.cos(ang), jnp.sin(ang)


def apply_partial_rope(x, cos, sin):
    half = cos.shape[-1]
    c = cos.astype(x.dtype)
    s = sin.astype(x.dtype)
    x1, x2, xp = x[..., :half], x[..., half:2 * half], x[..., 2 * half:]
    return jnp.concatenate([x1 * c - x2 * s, x2 * c + x1 * s, xp], axis=-1)


def diff_attention(q, k, v, lam, lam_init, norm_g):
    B, H, _, S, dq = q.shape
    nb = S // Q_BLOCK
    qb = q.reshape(B, H, 2, nb, Q_BLOCK, dq).transpose(3, 0, 1, 2, 4, 5)
    scale = dq ** -0.5

    def block(q_blk):
        s = jnp.einsum('bhmqd,bhmkd->bhmqk', q_blk, k).astype(jnp.float32) * scale
        p = jax.nn.softmax(s, axis=-1)
        pd = p[:, :, 0] - lam * p[:, :, 1]
        return jnp.einsum('bhqk,bhkd->bhqd', pd.astype(v.dtype), v)

    o = lax.map(block, qb)
    o = o.transpose(1, 2, 0, 3, 4).reshape(B, H, S, v.shape[-1])
    return rms_norm(o, norm_g) * (1.0 - lam_init)


def dilated_branch(q, k, v, window, dilation):
    B, H, S, dh = q.shape
    half = window // (2 * dilation)
    assert half <= SW_BLOCK
    L = S // dilation
    nb = -(-L // SW_BLOCK)
    Lp = nb * SW_BLOCK

    def by_residue(t):
        return t.reshape(B, H, L, dilation, dh).transpose(0, 1, 3, 2, 4)

    pad0 = ((0, 0), (0, 0), (0, 0))
    qs = jnp.pad(by_residue(q), pad0 + ((0, Lp - L), (0, 0)))
    ks = jnp.pad(by_residue(k), pad0 + ((SW_BLOCK, Lp - L + SW_BLOCK), (0, 0)))
    vs = jnp.pad(by_residue(v), pad0 + ((SW_BLOCK, Lp - L + SW_BLOCK), (0, 0)))
    qb = qs.reshape(B, H, dilation, nb, SW_BLOCK, dh)

    def band(t):
        tb = t.reshape(B, H, dilation, nb + 2, SW_BLOCK, dh)
        return jnp.concatenate([tb[:, :, :, j:j + nb] for j in range(3)], axis=-2)

    kb, vb = band(ks), band(vs)
    qpos = np.arange(nb)[:, None] * SW_BLOCK + np.arange(SW_BLOCK)[None, :]
    kpos = (np.arange(nb)[:, None] - 1) * SW_BLOCK + np.arange(3 * SW_BLOCK)[None, :]
    delta = kpos[:, None, :] - qpos[:, :, None]
    mask = (np.abs(delta) <= half) & (kpos[:, None, :] >= 0) & (kpos[:, None, :] < L)
    s = jnp.einsum('bhrnqd,bhrnkd->bhrnqk', qb, kb).astype(jnp.float32) * dh ** -0.5
    s = jnp.where(mask, s, NEG)
    lse = jax.nn.logsumexp(s, axis=-1)
    p = jnp.exp(s - lse[..., None])
    o = jnp.einsum('bhrnqk,bhrnkd->bhrnqd', p.astype(v.dtype), vb)
    o = o.reshape(B, H, dilation, Lp, dh)[:, :, :, :L].transpose(0, 1, 3, 2, 4).reshape(B, H, S, dh)
    lse = lse.reshape(B, H, dilation, Lp)[:, :, :, :L].transpose(0, 1, 3, 2).reshape(B, H, S)
    return o, lse


def dilated_attention(q, k, v):
    outs, lses = [], []
    for window, dilation in DILATED_CONFIGS:
        o, lse = dilated_branch(q, k, v, window, dilation)
        outs.append(o)
        lses.append(lse)
    wts = jax.nn.softmax(jnp.stack(lses, axis=0), axis=0)
    return jnp.einsum('gbhs,gbhsd->bhsd', wts.astype(v.dtype), jnp.stack(outs, axis=0))


def neighbourhood_attention(q, k, v, rpb):
    B, H, S, dh = q.shape
    rows = S // GRID_W
    kh = min(NA_ROWS_MAX, rows)
    kw = NA_COLS
    r = np.arange(rows)
    row_start = np.clip(r - kh // 2, 0, rows - kh)
    key_rows = row_start[:, None] + np.arange(kh)[None, :]
    tok = (key_rows[:, :, None] * GRID_W + np.arange(GRID_W)[None, None, :]).reshape(rows, kh * GRID_W)
    kg = jnp.take(k, tok, axis=2)
    vg = jnp.take(v, tok, axis=2)
    qg = q.reshape(B, H, rows, GRID_W, dh)
    c = np.arange(GRID_W)
    col_start = np.clip(c - kw // 2, 0, GRID_W - kw)
    kcol = np.tile(np.arange(GRID_W), kh)
    valid = (kcol[None, :] >= col_start[:, None]) & (kcol[None, :] < col_start[:, None] + kw)
    ridx = np.repeat(key_rows, GRID_W, axis=1) - r[:, None] + NA_ROWS_MAX - 1
    cidx = np.clip(kcol[None, :] - c[:, None] + kw - 1, 0, 2 * kw - 2)
    bias = rpb[:, ridx[:, None, :], cidx[None, :, :]].astype(jnp.float32)
    bias = jnp.where(valid[None, None], bias, NEG)
    s = jnp.einsum('bhrqd,bhrkd->bhrqk', qg, kg).astype(jnp.float32) * dh ** -0.5 + bias[None]
    p = jax.nn.softmax(s, axis=-1)
    o = jnp.einsum('bhrqk,bhrkd->bhrqd', p.astype(v.dtype), vg)
    return o.reshape(B, H, S, dh)


def hybrid_mixer(x, w_in, w_out, beta_mix, diff_lambda, diff_norm_g, na_rpb, lam_init, rope_a, rope_b):
    B, S, _ = x.shape
    proj = x @ w_in
    pa, pb, pc = jnp.split(proj, [3 * WIDTH_A, 3 * WIDTH_A + 3 * WIDTH_B], axis=-1)

    def heads(t, n):
        return t.reshape(B, S, n, HEAD_DIM).transpose(0, 2, 1, 3)

    def diff_heads(t):
        return t.reshape(B, S, N_HEADS_A, 2, DIFF_DIM).transpose(0, 2, 3, 1, 4)

    qa, ka, va = jnp.split(pa, 3, axis=-1)
    qa = apply_partial_rope(diff_heads(qa), *rope_a)
    ka = apply_partial_rope(diff_heads(ka), *rope_a)
    lam_p = diff_lambda.astype(jnp.float32)
    lam = jnp.exp(jnp.sum(lam_p[0] * lam_p[1])) - jnp.exp(jnp.sum(lam_p[2] * lam_p[3])) + lam_init
    oa = diff_attention(qa, ka, heads(va, N_HEADS_A), lam, lam_init, diff_norm_g)

    qb, kb, vb = jnp.split(pb, 3, axis=-1)
    qb = apply_partial_rope(heads(qb, N_HEADS_B), *rope_b)
    kb = apply_partial_rope(heads(kb, N_HEADS_B), *rope_b)
    ob = dilated_attention(qb, kb, heads(vb, N_HEADS_B))

    qc, kc, vc = jnp.split(pc, 3, axis=-1)
    oc = neighbourhood_attention(heads(qc, N_HEADS_C), heads(kc, N_HEADS_C), heads(vc, N_HEADS_C), na_rpb)

    merged = jnp.concatenate([oa, ob, oc], axis=1).transpose(0, 2, 1, 3).reshape(B, S, MIX_WIDTH)
    return (merged * beta_mix) @ w_out


def swiglu(x, w_gate, w_up, w_down):
    return (jax.nn.silu(x @ w_gate) * (x @ w_up)) @ w_down


def moe_swiglu(x, w_router, w_gate, w_up, w_down):
    logits = (x @ w_router).astype(jnp.float32)
    top_v, top_i = lax.top_k(logits, TOP_K)
    gates = jax.nn.softmax(top_v, axis=-1)
    combine = jnp.sum(jax.nn.one_hot(top_i, N_EXPERTS, dtype=jnp.float32) * gates[..., None], axis=-2)
    out = jnp.zeros_like(x)
    for e in range(N_EXPERTS):
        out = out + combine[..., e:e + 1].astype(x.dtype) * swiglu(x, w_gate[e], w_up[e], w_down[e])
    return out


def setup_inputs(seed: int = 0) -> dict:
    key = jax.random.key(seed)
    ks = jax.random.split(key, 18)
    D = D_MODEL
    f32 = jnp.float32

    def nrm(k, shape, scale):
        return jax.random.normal(k, shape, f32) * scale

    col_scale = np.ones(3 * MIX_WIDTH, np.float32)
    off = 0
    for w in (WIDTH_A, WIDTH_B, WIDTH_C):
        col_scale[off + 2 * w: off + 3 * w] = DEEPNORM_BETA
        off += 3 * w
    return {
        'x': nrm(ks[0], (BATCH, SEQ, D), 1.0),
        'w_in': nrm(ks[1], (DEPTH, D, 3 * MIX_WIDTH), D ** -0.5) * jnp.asarray(col_scale),
        'w_out': nrm(ks[2], (DEPTH, MIX_WIDTH, D), MIX_WIDTH ** -0.5 * DEEPNORM_BETA),
        'beta_mix': 1.0 + nrm(ks[3], (DEPTH, MIX_WIDTH), 0.02),
        'diff_lambda': nrm(ks[4], (DEPTH, 4, DIFF_DIM), 0.1),
        'diff_norm_g': 1.0 + nrm(ks[5], (DEPTH, HEAD_DIM), 0.02),
        'na_rpb': nrm(ks[6], (DEPTH, N_HEADS_C, 2 * NA_ROWS_MAX - 1, 2 * NA_COLS - 1), 0.02),
        'ln1_g': 1.0 + nrm(ks[7], (DEPTH, D), 0.02),
        'ln1_b': nrm(ks[8], (DEPTH, D), 0.02),
        'ln2_g': 1.0 + nrm(ks[9], (DEPTH, D), 0.02),
        'ln2_b': nrm(ks[10], (DEPTH, D), 0.02),
        'ffn_w_gate': nrm(ks[11], (N_DENSE, D, D_FF_DENSE), D ** -0.5),
        'ffn_w_up': nrm(ks[12], (N_DENSE, D, D_FF_DENSE), D ** -0.5),
        'ffn_w_down': nrm(ks[13], (N_DENSE, D_FF_DENSE, D), D_FF_DENSE ** -0.5 * DEEPNORM_BETA),
        'moe_w_router': nrm(ks[14], (N_MOE, D, N_EXPERTS), D ** -0.5),
        'moe_w_gate': nrm(ks[15], (N_MOE, N_EXPERTS, D, D_FF_EXPERT), D ** -0.5),
        'moe_w_up': nrm(ks[16], (N_MOE, N_EXPERTS, D, D_FF_EXPERT), D ** -0.5),
        'moe_w_down': nrm(ks[17], (N_MOE, N_EXPERTS, D_FF_EXPERT, D), D_FF_EXPERT ** -0.5 * DEEPNORM_BETA),
    }


def reference(x, w_in, w_out, beta_mix, diff_lambda, diff_norm_g, na_rpb, ln1_g, ln1_b, ln2_g, ln2_b,
              ffn_w_gate, ffn_w_up, ffn_w_down, moe_w_router, moe_w_gate, moe_w_up, moe_w_down):
    S = x.shape[1]
    rope_a = rope_tables(S, DIFF_DIM // ROPE_FRACTION)
    rope_b = rope_tables(S, HEAD_DIM // ROPE_FRACTION)
    for l in range(DEPTH):
        lam_init = 0.8 - 0.6 * math.exp(-0.3 * l)
        mix = hybrid_mixer(x, w_in[l], w_out[l], beta_mix[l], diff_lambda[l], diff_norm_g[l], na_rpb[l],
                           lam_init, rope_a, rope_b)
        x = layer_norm(DEEPNORM_ALPHA * x + mix, ln1_g[l], ln1_b[l])
        if l % 2 == 0:
            j = l // 2
            f = swiglu(x, ffn_w_gate[j], ffn_w_up[j], ffn_w_down[j])
        else:
            j = l // 2
            f = moe_swiglu(x, moe_w_router[j], moe_w_gate[j], moe_w_up[j], moe_w_down[j])
        x = layer_norm(DEEPNORM_ALPHA * x + f, ln2_g[l], ln2_b[l])
    return x
```

```cpp
#include <hip/hip_runtime.h>
#include <stdint.h>
#include <math.h>

namespace nv {
constexpr int D = 1024, BATCH = 8, SEQ = 2048, M = BATCH * SEQ, DEPTH = 2;
constexpr int NQKV = 3072;
constexpr int DFF = 2816, NEXP = 8, DFE = 3584;
constexpr float LN_EPS = 1e-5f;
constexpr float ALPHA = 1.41421356237309515f;
constexpr float ROPE_THETA = 500000.0f;

template <int EPI>
__global__ __launch_bounds__(256) void k_gemm(const float* __restrict__ A, int lda, const int* __restrict__ rowidx, const int* __restrict__ mcount_ptr, int Mmax,
                                              const float* __restrict__ B0, const float* __restrict__ B1, int ldb, int N, int K,
                                              float* __restrict__ C, int ldc, const float* __restrict__ rowscale) {
    const int Mc = mcount_ptr ? *mcount_ptr : Mmax;
    const int m0 = blockIdx.y * 64, n0 = blockIdx.x * 64;
    if (m0 >= Mc) return;
    __shared__ float As[16][68];
    __shared__ float Bs0[16][64];
    __shared__ float Bs1[EPI == 1 ? 16 : 1][64];
    const int tid = threadIdx.x, tx = tid & 15, ty = tid >> 4;
    float acc0[4][4], acc1[4][4];
#pragma unroll
    for (int i = 0; i < 4; ++i)
#pragma unroll
        for (int j = 0; j < 4; ++j) { acc0[i][j] = 0.f; acc1[i][j] = 0.f; }
    const int ar = tid >> 2, ak = (tid & 3) * 4;
    const int am = m0 + ar;
    const bool avalid = am < Mc;
    long arow = 0;
    if (avalid) arow = (EPI != 2 && rowidx) ? (long)rowidx[am] : (long)am;
    const float* ap = A + arow * (long)lda + ak;
    const int bk = tid >> 4, bn = (tid & 15) * 4;
    for (int k0 = 0; k0 < K; k0 += 16) {
        float4 av = avalid ? *(const float4*)(ap + k0) : make_float4(0.f, 0.f, 0.f, 0.f);
        As[ak + 0][ar] = av.x; As[ak + 1][ar] = av.y; As[ak + 2][ar] = av.z; As[ak + 3][ar] = av.w;
        *(float4*)&Bs0[bk][bn] = *(const float4*)(B0 + (long)(k0 + bk) * ldb + n0 + bn);
        if (EPI == 1) *(float4*)&Bs1[bk][bn] = *(const float4*)(B1 + (long)(k0 + bk) * ldb + n0 + bn);
        __syncthreads();
#pragma unroll
        for (int kk = 0; kk < 16; ++kk) {
            float a[4], b[4], b1[4];
            *(float4*)a = *(const float4*)&As[kk][ty * 4];
            *(float4*)b = *(const float4*)&Bs0[kk][tx * 4];
            if (EPI == 1) *(float4*)b1 = *(const float4*)&Bs1[kk][tx * 4];
#pragma unroll
            for (int i = 0; i < 4; ++i)
#pragma unroll
                for (int j = 0; j < 4; ++j) { acc0[i][j] = fmaf(a[i], b[j], acc0[i][j]); if (EPI == 1) acc1[i][j] = fmaf(a[i], b1[j], acc1[i][j]); }
        }
        __syncthreads();
    }
#pragma unroll
    for (int i = 0; i < 4; ++i) {
        const int m = m0 + ty * 4 + i;
        if (m >= Mc) continue;
        if (EPI == 2) {
            const long r = rowidx[m]; const float s = rowscale[m];
#pragma unroll
            for (int j = 0; j < 4; ++j) { float* p = C + r * ldc + n0 + tx * 4 + j; *p = *p + s * acc0[i][j]; }
        } else {
#pragma unroll
            for (int j = 0; j < 4; ++j) {
                float v = acc0[i][j];
                if (EPI == 1) { const float g = acc0[i][j]; v = g / (1.f + expf(-g)) * acc1[i][j]; }
                C[(long)m * ldc + n0 + tx * 4 + j] = v;
            }
        }
    }
}

__global__ void k_rope_tables(float* ta, float* tb) {
    const int i = blockIdx.x * blockDim.x + threadIdx.x;
    if (i < SEQ * 4) { const int p = i / 4, j = i % 4; const float inv = powf(ROPE_THETA, -(float)(2 * j) / 8.0f); const float ang = (float)p * inv;
        ta[i] = (float)cos((double)ang); ta[SEQ * 4 + i] = (float)sin((double)ang); }
    if (i < SEQ * 8) { const int p = i / 8, j = i % 8; const float inv = powf(ROPE_THETA, -(float)(2 * j) / 16.0f); const float ang = (float)p * inv;
        tb[i] = (float)cos((double)ang); tb[SEQ * 8 + i] = (float)sin((double)ang); }
}
__global__ void k_rope(float* qkv, const float* ta, const float* tb) {
    const int i = blockIdx.x * blockDim.x + threadIdx.x;
    if (i >= M * 28) return;
    const int tok = i / 28, u = i % 28, pos = tok % SEQ;
    float* row = qkv + (long)tok * NQKV;
    if (u < 16) { const int qk = u / 8, hm = u % 8; float* p = row + qk * 256 + hm * 32;
        for (int j = 0; j < 4; ++j) { const float c = ta[pos * 4 + j], s = ta[SEQ * 4 + pos * 4 + j]; const float x1 = p[j], x2 = p[4 + j]; p[j] = x1 * c - x2 * s; p[4 + j] = x2 * c + x1 * s; } }
    else { const int v = u - 16, qk = v / 6, h = v % 6; float* p = row + 768 + qk * 384 + h * 64;
        for (int j = 0; j < 8; ++j) { const float c = tb[pos * 8 + j], s = tb[SEQ * 8 + pos * 8 + j]; const float x1 = p[j], x2 = p[8 + j]; p[j] = x1 * c - x2 * s; p[8 + j] = x2 * c + x1 * s; } }
}

__global__ __launch_bounds__(256) void k_attn_a_part(const float* __restrict__ qkv, float* __restrict__ tmp) {
    const int q = blockIdx.x * 256 + threadIdx.x;
    const int bhm = blockIdx.y;
    const int b = bhm / 8, h = (bhm % 8) / 2, m = bhm % 2;
    const float* base = qkv + (long)b * SEQ * NQKV;
    float qv[32];
    _Pragma("unroll") for (int d = 0; d < 32; ++d) qv[d] = base[(long)q * NQKV + h * 64 + m * 32 + d];
    const float scale = 0.17677669529663687f;
    float mx = -INFINITY;
    for (int k = 0; k < SEQ; ++k) { const float* kp = base + (long)k * NQKV + 256 + h * 64 + m * 32; float s = 0.f; _Pragma("unroll") for (int d = 0; d < 32; ++d) s = fmaf(qv[d], kp[d], s); mx = fmaxf(mx, s * scale); }
    float l = 0.f, o[64];
    _Pragma("unroll") for (int d = 0; d < 64; ++d) o[d] = 0.f;
    for (int k = 0; k < SEQ; ++k) { const float* kp = base + (long)k * NQKV + 256 + h * 64 + m * 32; float s = 0.f; _Pragma("unroll") for (int d = 0; d < 32; ++d) s = fmaf(qv[d], kp[d], s);
        const float p = expf(s * scale - mx); l += p; const float* vp = base + (long)k * NQKV + 512 + h * 64; _Pragma("unroll") for (int d = 0; d < 64; ++d) o[d] = fmaf(p, vp[d], o[d]); }
    const float inv = 1.f / l;
    float* op = tmp + ((long)bhm * SEQ + q) * 64;
    _Pragma("unroll") for (int d = 0; d < 64; ++d) op[d] = o[d] * inv;
}
__global__ void k_attn_a_fin(const float* __restrict__ tmp, const float* __restrict__ lamp  , const float* __restrict__ ng  , float lam_init, float* __restrict__ O  ) {
    const int i = blockIdx.x * blockDim.x + threadIdx.x;
    if (i >= BATCH * 4 * SEQ) return;
    const int q = i % SEQ, h = (i / SEQ) % 4, b = i / (SEQ * 4);
    float s01 = 0.f, s23 = 0.f;
    _Pragma("unroll") for (int d = 0; d < 32; ++d) { s01 += lamp[d] * lamp[32 + d]; s23 += lamp[64 + d] * lamp[96 + d]; }
    const float lam = expf(s01) - expf(s23) + lam_init;
    const float* t0 = tmp + ((long)(b * 8 + h * 2 + 0) * SEQ + q) * 64; const float* t1 = tmp + ((long)(b * 8 + h * 2 + 1) * SEQ + q) * 64;
    float o[64], ss = 0.f;
    _Pragma("unroll") for (int d = 0; d < 64; ++d) { o[d] = t0[d] - lam * t1[d]; ss += o[d] * o[d]; }
    const float r = rsqrtf(ss / 64.f + LN_EPS) * (1.0f - lam_init);
    float* op = O + ((long)b * SEQ + q) * D + h * 64;
    _Pragma("unroll") for (int d = 0; d < 64; ++d) op[d] = o[d] * r * ng[d];
}

__global__ __launch_bounds__(256) void k_attn_b(const float* __restrict__ qkv, float* __restrict__ O) {
    const int q = blockIdx.x * 256 + threadIdx.x; const int bh = blockIdx.y; const int b = bh / 6, h = bh % 6;
    const float* base = qkv + (long)b * SEQ * NQKV;
    float qv[64];
    _Pragma("unroll") for (int d = 0; d < 64; ++d) qv[d] = base[(long)q * NQKV + 768 + h * 64 + d];
    const float scale = 0.125f;
    float acc[64], og[64];
    _Pragma("unroll") for (int d = 0; d < 64; ++d) acc[d] = 0.f;
    float ml = -INFINITY, wsum = 0.f;
#pragma unroll 1
    for (int g = 0; g < 3; ++g) {
        const int dil = g == 0 ? 1 : (g == 1 ? 4 : 16);
        float mx = -INFINITY;
#pragma unroll 1
        for (int j = -64; j <= 64; ++j) { const int kp = q + j * dil; if (kp < 0 || kp >= SEQ) continue; const float* kr = base + (long)kp * NQKV + 1152 + h * 64; float s = 0.f;
            _Pragma("unroll") for (int d = 0; d < 64; ++d) s = fmaf(qv[d], kr[d], s);
            mx = fmaxf(mx, s * scale); }
        float l = 0.f;
        _Pragma("unroll") for (int d = 0; d < 64; ++d) og[d] = 0.f;
#pragma unroll 1
        for (int j = -64; j <= 64; ++j) { const int kp = q + j * dil; if (kp < 0 || kp >= SEQ) continue; const float* kr = base + (long)kp * NQKV + 1152 + h * 64; float s = 0.f;
            _Pragma("unroll") for (int d = 0; d < 64; ++d) s = fmaf(qv[d], kr[d], s);
            const float p = expf(s * scale - mx); l += p; const float* vr = base + (long)kp * NQKV + 1536 + h * 64;
            _Pragma("unroll") for (int d = 0; d < 64; ++d) og[d] = fmaf(p, vr[d], og[d]); }
        const float lse = mx + logf(l);
        const float nml = fmaxf(ml, lse); const float a = expf(ml - nml), w = expf(lse - nml); const float wi = w / l;
        _Pragma("unroll") for (int d = 0; d < 64; ++d) acc[d] = acc[d] * a + og[d] * wi;
        wsum = wsum * a + w; ml = nml;
    }
    const float ws = 1.f / wsum;
    float* op = O + ((long)b * SEQ + q) * D + 256 + h * 64;
    _Pragma("unroll") for (int d = 0; d < 64; ++d) op[d] = acc[d] * ws;
}

__global__ __launch_bounds__(256) void k_attn_c(const float* __restrict__ qkv, const float* __restrict__ rpb  , float* __restrict__ O) {
    const int q = blockIdx.x * 256 + threadIdx.x; const int bh = blockIdx.y; const int b = bh / 6, h = bh % 6;
    const float* base = qkv + (long)b * SEQ * NQKV;
    float qv[64]; _Pragma("unroll") for (int d = 0; d < 64; ++d) qv[d] = base[(long)q * NQKV + 1920 + h * 64 + d];
    const int r = q / 64, c = q % 64;
    int rs = r - 4; rs = rs < 0 ? 0 : (rs > 24 ? 24 : rs);
    int cs = c - 8; cs = cs < 0 ? 0 : (cs > 48 ? 48 : cs);
    const float scale = 0.125f;
    float mx = -INFINITY;
    for (int kr = rs; kr < rs + 8; ++kr) for (int kc = cs; kc < cs + 16; ++kc) {
        const float* kp = base + (long)(kr * 64 + kc) * NQKV + 2304 + h * 64; float s = 0.f; _Pragma("unroll") for (int d = 0; d < 64; ++d) s = fmaf(qv[d], kp[d], s);
        s = s * scale + rpb[(h * 15 + (kr - r + 7)) * 31 + (kc - c + 15)]; mx = fmaxf(mx, s); }
    float l = 0.f, o[64]; _Pragma("unroll") for (int d = 0; d < 64; ++d) o[d] = 0.f;
    for (int kr = rs; kr < rs + 8; ++kr) for (int kc = cs; kc < cs + 16; ++kc) {
        const float* kp = base + (long)(kr * 64 + kc) * NQKV + 2304 + h * 64; float s = 0.f; _Pragma("unroll") for (int d = 0; d < 64; ++d) s = fmaf(qv[d], kp[d], s);
        s = s * scale + rpb[(h * 15 + (kr - r + 7)) * 31 + (kc - c + 15)]; const float p = expf(s - mx); l += p;
        const float* vp = base + (long)(kr * 64 + kc) * NQKV + 2688 + h * 64; _Pragma("unroll") for (int d = 0; d < 64; ++d) o[d] = fmaf(p, vp[d], o[d]); }
    const float inv = 1.f / l;
    float* op = O + ((long)b * SEQ + q) * D + 640 + h * 64;
    _Pragma("unroll") for (int d = 0; d < 64; ++d) op[d] = o[d] * inv;
}

__global__ void k_scale_cols(float* O, const float* beta) { const long i = (long)blockIdx.x * blockDim.x + threadIdx.x; if (i < (long)M * D) O[i] *= beta[i % D]; }

__global__ __launch_bounds__(256) void k_ln(const float* __restrict__ x, const float* __restrict__ y, const float* __restrict__ g, const float* __restrict__ bb, float* __restrict__ out) {
    const int row = blockIdx.x * 4 + (threadIdx.x >> 6), lane = threadIdx.x & 63;
    const float* xp = x + (long)row * D; const float* yp = y + (long)row * D;
    float v[16]; float s = 0.f;
    for (int i = 0; i < 16; ++i) { v[i] = ALPHA * xp[lane + 64 * i] + yp[lane + 64 * i]; s += v[i]; }
    for (int o = 32; o > 0; o >>= 1) s += __shfl_xor(s, o);
    const float mu = s / D; float q = 0.f;
    for (int i = 0; i < 16; ++i) { const float d = v[i] - mu; q += d * d; }
    for (int o = 32; o > 0; o >>= 1) q += __shfl_xor(q, o);
    const float rs = rsqrtf(q / D + LN_EPS);
    for (int i = 0; i < 16; ++i) out[(long)row * D + lane + 64 * i] = (v[i] - mu) * rs * g[lane + 64 * i] + bb[lane + 64 * i];
}

__global__ __launch_bounds__(256) void k_router(const float* __restrict__ x, const float* __restrict__ wr  , int* __restrict__ cnt, int* __restrict__ lists, float* __restrict__ gates) {
    const int tok = blockIdx.x * 4 + (threadIdx.x >> 6), lane = threadIdx.x & 63;
    float lg[8]; for (int e = 0; e < 8; ++e) lg[e] = 0.f;
    for (int i = 0; i < 16; ++i) { const int k = lane + 64 * i; const float xv = x[(long)tok * D + k]; for (int e = 0; e < 8; ++e) lg[e] = fmaf(xv, wr[k * 8 + e], lg[e]); }
    for (int e = 0; e < 8; ++e) for (int o = 32; o > 0; o >>= 1) lg[e] += __shfl_xor(lg[e], o);
    if (lane == 0) {
        int i0 = 0; for (int e = 1; e < 8; ++e) if (lg[e] > lg[i0]) i0 = e;
        int i1 = -1; for (int e = 0; e < 8; ++e) { if (e == i0) continue; if (i1 < 0 || lg[e] > lg[i1]) i1 = e; }
        const float e1 = expf(lg[i1] - lg[i0]); const float g0 = 1.f / (1.f + e1), g1 = e1 / (1.f + e1);
        int p0 = atomicAdd(&cnt[i0], 1); lists[i0 * M + p0] = tok; gates[i0 * M + p0] = g0;
        int p1 = atomicAdd(&cnt[i1], 1); lists[i1 * M + p1] = tok; gates[i1 * M + p1] = g1;
    }
}
}

extern "C" void kernel_launch(void* const* d_in, const int* in_sizes, int n_in, void* d_out, int out_size, void* d_ws, size_t ws_size, hipStream_t stream) {
    using namespace nv;
    const float* x_in = (const float*)d_in[0];
    const float* w_in = (const float*)d_in[1];
    const float* w_out = (const float*)d_in[2];
    const float* beta_mix = (const float*)d_in[3];
    const float* diff_lambda = (const float*)d_in[4];
    const float* diff_norm_g = (const float*)d_in[5];
    const float* na_rpb = (const float*)d_in[6];
    const float* ln1_g = (const float*)d_in[7];
    const float* ln1_b = (const float*)d_in[8];
    const float* ln2_g = (const float*)d_in[9];
    const float* ln2_b = (const float*)d_in[10];
    const float* ffn_w_gate = (const float*)d_in[11];
    const float* ffn_w_up = (const float*)d_in[12];
    const float* ffn_w_down = (const float*)d_in[13];
    const float* moe_w_router = (const float*)d_in[14];
    const float* moe_w_gate = (const float*)d_in[15];
    const float* moe_w_up = (const float*)d_in[16];
    const float* moe_w_down = (const float*)d_in[17];
    float* out = (float*)d_out;

    char* ws = (char*)d_ws; size_t off = 0;
    auto take = [&](size_t bytes) { char* p = ws + off; off += (bytes + 255) & ~(size_t)255; return p; };
    float* ta = (float*)take(SEQ * 4 * 2 * 4);
    float* tb = (float*)take(SEQ * 8 * 2 * 4);
    int* cnt = (int*)take(256);
    int* lists = (int*)take((size_t)NEXP * M * 4);
    float* gates = (float*)take((size_t)NEXP * M * 4);
    float* x1 = (float*)take((size_t)M * D * 4);
    float* Obuf = (float*)take((size_t)M * D * 4);
    float* mix = (float*)take((size_t)M * D * 4);
    float* big = (float*)take((size_t)M * DFE * 4);
    float* tmpA = mix;

    k_rope_tables<<<(SEQ * 8 + 255) / 256, 256, 0, stream>>>(ta, tb);
    const float* xcur = x_in;
    for (int l = 0; l < DEPTH; ++l) {
        const float lam_init = 0.8f - 0.6f * expf(-0.3f * (float)l);
        k_gemm<0><<<dim3(NQKV / 64, M / 64), 256, 0, stream>>>(xcur, D, nullptr, nullptr, M, w_in + (size_t)l * D * NQKV, nullptr, NQKV, NQKV, D, big, NQKV, nullptr);
        k_rope<<<(M * 28 + 255) / 256, 256, 0, stream>>>(big, ta, tb);
        k_attn_a_part<<<dim3(SEQ / 256, BATCH * 8), 256, 0, stream>>>(big, tmpA);
        k_attn_a_fin<<<(BATCH * 4 * SEQ + 255) / 256, 256, 0, stream>>>(tmpA, diff_lambda + l * 128, diff_norm_g + l * 64, lam_init, Obuf);
        k_attn_b<<<dim3(SEQ / 256, BATCH * 6), 256, 0, stream>>>(big, Obuf);
        k_attn_c<<<dim3(SEQ / 256, BATCH * 6), 256, 0, stream>>>(big, na_rpb + (size_t)l * 6 * 15 * 31, Obuf);
        k_scale_cols<<<(unsigned)(((long)M * D + 255) / 256), 256, 0, stream>>>(Obuf, beta_mix + l * D);
        k_gemm<0><<<dim3(D / 64, M / 64), 256, 0, stream>>>(Obuf, D, nullptr, nullptr, M, w_out + (size_t)l * D * D, nullptr, D, D, D, mix, D, nullptr);
        k_ln<<<M / 4, 256, 0, stream>>>(xcur, mix, ln1_g + l * D, ln1_b + l * D, x1);
        float* xnext = out;
        if (l % 2 == 0) {
            const int j = l / 2;
            k_gemm<1><<<dim3(DFF / 64, M / 64), 256, 0, stream>>>(x1, D, nullptr, nullptr, M, ffn_w_gate + (size_t)j * D * DFF, ffn_w_up + (size_t)j * D * DFF, DFF, DFF, D, big, DFF, nullptr);
            k_gemm<0><<<dim3(D / 64, M / 64), 256, 0, stream>>>(big, DFF, nullptr, nullptr, M, ffn_w_down + (size_t)j * DFF * D, nullptr, D, D, DFF, mix, D, nullptr);
        } else {
            const int j = l / 2;
            hipMemsetAsync(cnt, 0, 256, stream);
            hipMemsetAsync(mix, 0, (size_t)M * D * 4, stream);
            k_router<<<M / 4, 256, 0, stream>>>(x1, moe_w_router + (size_t)j * D * NEXP, cnt, lists, gates);
            for (int e = 0; e < NEXP; ++e) {
                const size_t wo = ((size_t)j * NEXP + e) * D * DFE;
                k_gemm<1><<<dim3(DFE / 64, M / 64), 256, 0, stream>>>(x1, D, lists + (size_t)e * M, cnt + e, M, moe_w_gate + wo, moe_w_up + wo, DFE, DFE, D, big, DFE, nullptr);
                k_gemm<2><<<dim3(D / 64, M / 64), 256, 0, stream>>>(big, DFE, lists + (size_t)e * M, cnt + e, M, moe_w_down + wo, nullptr, D, D, DFE, mix, D, gates + (size_t)e * M);
            }
        }
        k_ln<<<M / 4, 256, 0, stream>>>(x1, mix, ln2_g + l * D, ln2_b + l * D, xnext);
        xcur = xnext;
    }
}
```

```cpp
#include <hip/hip_runtime.h>
#include <cstdio>
#include <cstdint>
#include <math.h>
#ifndef PROBE_THR
#define PROBE_THR 1e-4f
#endif
namespace pg8 {
#define PG8_LAS __attribute__((address_space(3)))
typedef unsigned short bf16_t;
typedef short bf16x8 __attribute__((ext_vector_type(8)));
typedef float f32x4 __attribute__((ext_vector_type(4)));
typedef unsigned u32x4 __attribute__((ext_vector_type(4)));
constexpr int BM = 256, BK = 64, HALF = 128, HTB = HALF * BK * 2  , STAGE_BYTES = 8 * HTB, NXCD = 8, WGM = 8;

__host__ __device__ __forceinline__ int lds_byte(int r, int c) { const int st = (r >> 4) * 2 + (c >> 5), rr = r & 15, cc = c & 31, ob = rr * 64 + cc * 2; return st * 1024 + (ob ^ (((ob >> 9) & 1) << 5)); }
__host__ __device__ __forceinline__ void stage_rc(int b, int& R, int& C) { const int st = b / 1024, sb = b % 1024, swz = sb ^ (((sb >> 9) & 1) << 5); R = (st >> 1) * 16 + swz / 64; C = (st & 1) * 32 + (swz % 64) / 2; }
__host__ __device__ __forceinline__ int perm32(int rho) { const int n = rho >> 4, i = rho & 15; return 8 * (i >> 2) + 4 * n + (i & 3); }

struct Unit { int pm, pn; };
struct Gemm { const bf16_t* A; const bf16_t* Bt; int M, N, K; };

struct StaticOrder {
    int nM, nN, nwg, G, c;
    __host__ __device__ void init(int M, int N, int G_, int c_) { nM = M / BM; nN = N / BM; nwg = nM * nN; G = G_; c = c_; }
    __host__ __device__ bool next(int i, Unit& u) const {
        const long L = (long)i * G + c; if (L >= nwg) return false;
        int wgid = (int)L; { const int q = nwg / NXCD, r = nwg % NXCD, xcd = wgid % NXCD, off = wgid / NXCD; wgid = (xcd < r ? xcd * (q + 1) : r * (q + 1) + (xcd - r) * q) + off; }
        const int nig = WGM * nN, gid = wgid / nig, fm = gid * WGM, gsz = (nM - fm) < WGM ? (nM - fm) : WGM;
        u.pm = fm + ((wgid % nig) % gsz); u.pn = (wgid % nig) / gsz; return true;
    }
    __device__ __forceinline__ void a_ready(const Unit&) const {}
    __device__ __forceinline__ void done(const Unit&) const {}
};

__device__ __forceinline__ unsigned cvt_pk_bf16(float lo, float hi) { unsigned r; asm volatile("v_cvt_pk_bf16_f32 %0, %1, %2" : "=v"(r) : "v"(lo), "v"(hi)); return r; }
typedef float f32x2 __attribute__((ext_vector_type(2)));
__device__ __forceinline__ f32x2 gelu_pk(f32x2 v) {
    const f32x2 av = __builtin_elementwise_abs(v), d = av * 0.2316418882f + 1.0f;
    f32x2 t; t.x = __builtin_amdgcn_rcpf(d.x); t.y = __builtin_amdgcn_rcpf(d.y);
    f32x2 q = t * 0.5307027145f + (-0.7265760135f); q = q * t + 0.7107068705f; q = q * t + (-0.142248368f); q = q * t + 0.127414796f; q = q * t;
    const f32x2 s = (v * v) * (-0.72134752044f);
    f32x2 e; e.x = __builtin_amdgcn_exp2f(s.x); e.y = __builtin_amdgcn_exp2f(s.y);
    const f32x2 m = v * (q * e), r = v - m;
    f32x2 o; o.x = v.x < 0.f ? m.x : r.x; o.y = v.y < 0.f ? m.y : r.y; return o;
}

constexpr float LOG2E = 1.4426950408889634f;
constexpr float QSCALE_A = 0.17677669529663687f * LOG2E;
constexpr float QSCALE_BC = 0.125f * LOG2E;
struct EpiQKV {
    static constexpr bool PERM = true, AFTER_DRAIN = false;
    bf16_t* O; const float* ropeA; const float* ropeB;
    __device__ __forceinline__ void operator()(const f32x4 (&acc)[2][2][4][2], const Unit& u, int wr, int wc, int fr, int fq) const {
        const int row0 = u.pm * BM + wr * 64 + fr;
#pragma unroll
        for (int bj = 0; bj < 2; ++bj) {
            const int c0 = u.pn * BM + bj * HALF + wc * 32 + 8 * fq;
            int mode = 0, j0 = 0; float sc = 1.f;
            if (c0 < 512) { if ((c0 & 31) == 0) mode = 1; if (c0 < 256) sc = QSCALE_A; }
            else if (c0 >= 768 && c0 < 1536) { const int ho = (c0 - 768) & 63; if (ho == 0) { mode = 2; j0 = 0; } else if (ho == 8) { mode = 2; j0 = 4; } if (c0 < 1152) sc = QSCALE_BC; }
            else if (c0 >= 1920 && c0 < 2304) sc = QSCALE_BC;
#pragma unroll
            for (int ai = 0; ai < 2; ++ai)
#pragma unroll
                for (int m = 0; m < 4; ++m) {
                    const int row = row0 + ai * HALF + m * 16; const int pos = row & 2047;
                    f32x4 v0 = acc[ai][bj][m][0], v1 = acc[ai][bj][m][1];
                    if (mode == 1) { const f32x4 c = *(const f32x4*)(ropeA + pos * 8), s = *(const f32x4*)(ropeA + pos * 8 + 4); const f32x4 a = v0 * c - v1 * s, b = v1 * c + v0 * s; v0 = a; v1 = b; }
                    else if (mode == 2) { const f32x4 c = *(const f32x4*)(ropeB + pos * 16 + j0), s = *(const f32x4*)(ropeB + pos * 16 + 8 + j0); const f32x4 a = v0 * c - v1 * s, b = v1 * c + v0 * s; v0 = a; v1 = b; }
                    v0 = v0 * sc; v1 = v1 * sc;
                    u32x4 w; w.x = cvt_pk_bf16(v0[0], v0[1]); w.y = cvt_pk_bf16(v0[2], v0[3]); w.z = cvt_pk_bf16(v1[0], v1[1]); w.w = cvt_pk_bf16(v1[2], v1[3]);
                    *(u32x4*)(O + (size_t)row * 3072 + c0) = w;
                }
        }
    }
};
struct EpiStoreBf16 {
    static constexpr bool PERM = true, AFTER_DRAIN = false;
    bf16_t* O; int ldc; int pm_off; int pn_mod;
    __device__ __forceinline__ void operator()(const f32x4 (&acc)[2][2][4][2], const Unit& u, int wr, int wc, int fr, int fq) const {
        const int row0 = (u.pm + pm_off) * BM + wr * 64 + fr; const int col0 = (u.pn % pn_mod) * BM + wc * 32 + 8 * fq;
#pragma unroll
        for (int ai = 0; ai < 2; ++ai)
#pragma unroll
            for (int m = 0; m < 4; ++m) { bf16_t* rowp = O + (size_t)(row0 + ai * HALF + m * 16) * ldc + col0;
#pragma unroll
                for (int bj = 0; bj < 2; ++bj) { const f32x4 v0 = acc[ai][bj][m][0], v1 = acc[ai][bj][m][1];
                    u32x4 w; w.x = cvt_pk_bf16(v0[0], v0[1]); w.y = cvt_pk_bf16(v0[2], v0[3]); w.z = cvt_pk_bf16(v1[0], v1[1]); w.w = cvt_pk_bf16(v1[2], v1[3]);
                    *(u32x4*)(rowp + bj * HALF) = w; } }
    }
};
struct EpiSwiglu {
    static constexpr bool PERM = true, AFTER_DRAIN = false;
    bf16_t* O; int ldc; int pm_off; int pn_mod;
    __device__ __forceinline__ void operator()(const f32x4 (&acc)[2][2][4][2], const Unit& u, int wr, int wc, int fr, int fq) const {
        const int row0 = (u.pm + pm_off) * BM + wr * 64 + fr; const int col0 = (u.pn % pn_mod) * HALF + wc * 32 + 8 * fq;
#pragma unroll
        for (int ai = 0; ai < 2; ++ai)
#pragma unroll
            for (int m = 0; m < 4; ++m) {
                float h[8];
#pragma unroll
                for (int n = 0; n < 2; ++n)
#pragma unroll
                    for (int j = 0; j < 4; ++j) { const float g = acc[ai][0][m][n][j], up = acc[ai][1][m][n][j];
                        const float e = __builtin_amdgcn_exp2f(-g * LOG2E); h[n * 4 + j] = g * __builtin_amdgcn_rcpf(1.0f + e) * up; }
                u32x4 w; w.x = cvt_pk_bf16(h[0], h[1]); w.y = cvt_pk_bf16(h[2], h[3]); w.z = cvt_pk_bf16(h[4], h[5]); w.w = cvt_pk_bf16(h[6], h[7]);
                *(u32x4*)(O + (size_t)(row0 + ai * HALF + m * 16) * ldc + col0) = w;
            }
    }
};
struct GroupedOrder {
    int ntiles, tile0, NP, G, c, a_rel; const int* tile_expert;
    __device__ __forceinline__ bool next(int i, Unit& u) const {
        const long L = (long)i * G + c; if (L >= (long)ntiles * NP) return false;
        const int g = (int)(L / (8 * NP)), r = (int)(L % (8 * NP)); const int rem = ntiles - 8 * g, gsz = rem < 8 ? rem : 8;
        const int pnl = r / gsz, t = 8 * g + (r % gsz);
        const int e = __builtin_amdgcn_readfirstlane(tile_expert[tile0 + t]);
        u.pm = a_rel ? t : tile0 + t; u.pn = e * NP + pnl; return true;
    }
    __device__ __forceinline__ void a_ready(const Unit&) const {}
    __device__ __forceinline__ void done(const Unit&) const {}
};
template <class Epi, class Sched, bool ALIGN_EPI = false, bool SP2 = false>
__device__ __forceinline__ void gemm_phase(PG8_LAS unsigned char* lds, const Gemm g, const Sched& S, const Epi& E) {
    int tid_ = threadIdx.x; asm volatile("" : "+v"(tid_));
    const int tid = tid_, wid = __builtin_amdgcn_readfirstlane(tid >> 6), lane = tid & 63, wr = wid >> 2, wc = wid & 3, fr = lane & 15, fq = lane >> 4;
    const int K = g.K, nt = K / BK;
    unsigned voffA[2], voffB[2];
#pragma unroll
    for (int i = 0; i < 2; ++i) { int R, C; stage_rc(tid * 16 + i * 8192, R, C); const int Rb = Epi::PERM ? ((R & ~31) + perm32(R & 31)) : R;
        voffA[i] = (unsigned)(R * K + C) * 2u; voffB[i] = (unsigned)(Rb * K + C) * 2u; }
    const size_t kstep = (size_t)(BK * 2);
    const size_t hstep = (size_t)HALF * K * 2;
    const size_t tstep = 2 * hstep;
    const unsigned ldsw = (unsigned)wid * 1024u;
    const int aoff = lds_byte(wr * 64 + fr, fq * 8), boff = lds_byte(wc * 32 + fr, fq * 8);
#define PG8_SA(b, h) (((b) * 2 + (h)) * HTB)
#define PG8_SB(b, h) ((4 + (b) * 2 + (h)) * HTB)
#define PG8_STAGE(bufoff, gbase, voff) do { _Pragma("unroll") for (int _i = 0; _i < 2; ++_i) \
        __builtin_amdgcn_global_load_lds((const unsigned*)((const char*)(gbase) + (voff)[_i]), (PG8_LAS unsigned*)(lds + (bufoff) + ldsw + _i * 8192), 16, 0, 0); } while (0)
#define PG8_LDA(dst, b, h) do { _Pragma("unroll") for (int m = 0; m < 4; ++m) _Pragma("unroll") for (int k = 0; k < 2; ++k) dst[m][k] = *(const PG8_LAS bf16x8*)(lds + PG8_SA(b, h) + aoff + m * 2048 + k * 1024); } while (0)
#define PG8_LDB(dst, b, h) do { _Pragma("unroll") for (int n = 0; n < 2; ++n) _Pragma("unroll") for (int k = 0; k < 2; ++k) dst[n][k] = *(const PG8_LAS bf16x8*)(lds + PG8_SB(b, h) + boff + n * 2048 + k * 1024); } while (0)
#define PG8_MMA(ai, bj, At, Bt) do { __builtin_amdgcn_s_setprio(1); _Pragma("unroll") for (int m = 0; m < 4; ++m) _Pragma("unroll") for (int n = 0; n < 2; ++n) _Pragma("unroll") for (int k = 0; k < 2; ++k) \
        acc[ai][bj][m][n] = __builtin_amdgcn_mfma_f32_16x16x32_bf16(Bt[n][k], At[m][k], acc[ai][bj][m][n], 0, 0, 0); __builtin_amdgcn_s_setprio(0); } while (0)
#define PG8_WAIT_V(n) asm volatile("s_waitcnt vmcnt(" #n ")" ::: "memory")
#define PG8_WAIT_L(n) asm volatile("s_waitcnt lgkmcnt(" #n ")" ::: "memory")
#define PG8_BAR __builtin_amdgcn_s_barrier()
#define PG8_SCHED __builtin_amdgcn_sched_barrier(0)
    Unit cur, nxt; int ui = 0;
    if (!S.next(0, cur)) return;
    f32x4 acc[2][2][4][2];
#pragma unroll
    for (int a = 0; a < 2; ++a)
#pragma unroll
        for (int b = 0; b < 2; ++b)
#pragma unroll
            for (int m = 0; m < 4; ++m)
#pragma unroll
                for (int n = 0; n < 2; ++n) acc[a][b][m][n] = (f32x4){0.f, 0.f, 0.f, 0.f};
    bf16x8 At[4][2], B0[2][2], B1[2][2];
    const char* cA = (const char*)g.A + (size_t)cur.pm * tstep; const char* cB = (const char*)g.Bt + (size_t)cur.pn * tstep;
    S.a_ready(cur);
    if constexpr (SP2) {
        PG8_STAGE(PG8_SB(0, 0), cB, voffB); PG8_STAGE(PG8_SB(0, 1), cB + hstep, voffB); PG8_STAGE(PG8_SA(0, 0), cA, voffA); PG8_STAGE(PG8_SA(0, 1), cA + hstep, voffA);
        if (wr == 1) PG8_BAR;
        PG8_WAIT_V(2); PG8_BAR;
        PG8_STAGE(PG8_SB(1, 0), cB + kstep, voffB); PG8_STAGE(PG8_SA(1, 0), cA + kstep, voffA); PG8_STAGE(PG8_SB(1, 1), cB + hstep + kstep, voffB);
        PG8_WAIT_V(6); PG8_BAR;
    } else {
        PG8_STAGE(PG8_SB(0, 0), cB, voffB); PG8_STAGE(PG8_SA(0, 0), cA, voffA); PG8_STAGE(PG8_SB(0, 1), cB + hstep, voffB); PG8_STAGE(PG8_SA(0, 1), cA + hstep, voffA);
        if (wr == 1) PG8_BAR;
        PG8_WAIT_V(4); PG8_BAR;
        PG8_STAGE(PG8_SB(1, 0), cB + kstep, voffB); PG8_STAGE(PG8_SA(1, 0), cA + kstep, voffA); PG8_STAGE(PG8_SB(1, 1), cB + hstep + kstep, voffB);
        PG8_WAIT_V(6); PG8_BAR;
    }
    for (;;) {
        const bool has_next = S.next(ui + 1, nxt);
        const char* nA = has_next ? (const char*)g.A + (size_t)nxt.pm * tstep : cA; const char* nB = has_next ? (const char*)g.Bt + (size_t)nxt.pn * tstep : cB;
        for (int t = 0; t < nt; t += 2) {
            const bool last = (t == nt - 2);
            const char* a1 = cA + (size_t)(t + 1) * kstep;
            const char* a2 = last ? nA : cA + (size_t)(t + 2) * kstep; const char* b2 = last ? nB : cB + (size_t)(t + 2) * kstep;
            const char* a3 = a2 + kstep; const char* b3 = b2 + kstep;
            if (last && has_next) S.a_ready(nxt);
            if constexpr (SP2) {
            PG8_LDB(B0, 0, 0); PG8_LDB(B1, 0, 1); PG8_SCHED; PG8_LDA(At, 0, 0); PG8_STAGE(PG8_SA(1, 1), a1 + hstep, voffA);
            PG8_WAIT_V(8); PG8_WAIT_L(0); PG8_BAR; PG8_MMA(0, 0, At, B0); PG8_MMA(0, 1, At, B1); PG8_BAR; PG8_SCHED;
            PG8_LDA(At, 0, 1); PG8_STAGE(PG8_SB(0, 0), b2, voffB); PG8_STAGE(PG8_SB(0, 1), b2 + hstep, voffB); PG8_STAGE(PG8_SA(0, 0), a2, voffA);
            PG8_WAIT_V(8); PG8_WAIT_L(0); PG8_BAR; PG8_MMA(1, 0, At, B0); PG8_MMA(1, 1, At, B1); PG8_BAR; PG8_SCHED;
            PG8_LDB(B0, 1, 0); PG8_LDB(B1, 1, 1); PG8_SCHED; PG8_LDA(At, 1, 0); PG8_STAGE(PG8_SA(0, 1), a2 + hstep, voffA);
            PG8_WAIT_V(8); PG8_WAIT_L(0); PG8_BAR; PG8_MMA(0, 0, At, B0); PG8_MMA(0, 1, At, B1); PG8_BAR; PG8_SCHED;
            PG8_LDA(At, 1, 1); PG8_STAGE(PG8_SB(1, 0), b3, voffB); PG8_STAGE(PG8_SB(1, 1), b3 + hstep, voffB); PG8_STAGE(PG8_SA(1, 0), a3, voffA);
            PG8_WAIT_V(8); PG8_WAIT_L(0); PG8_BAR; PG8_MMA(1, 0, At, B0); PG8_MMA(1, 1, At, B1); PG8_BAR; PG8_SCHED;
            } else {
            PG8_LDB(B0, 0, 0); PG8_SCHED; PG8_LDA(At, 0, 0); PG8_STAGE(PG8_SA(1, 1), a1 + hstep, voffA);
            PG8_WAIT_L(8); PG8_BAR; PG8_WAIT_L(0); PG8_MMA(0, 0, At, B0); PG8_BAR; PG8_SCHED;
            PG8_LDB(B1, 0, 1); PG8_STAGE(PG8_SB(0, 0), b2, voffB);
            PG8_BAR; PG8_WAIT_L(0); PG8_MMA(0, 1, At, B1); PG8_BAR;
            PG8_LDA(At, 0, 1); PG8_STAGE(PG8_SA(0, 0), a2, voffA);
            PG8_BAR; PG8_WAIT_L(0); PG8_MMA(1, 0, At, B0); PG8_BAR; PG8_SCHED;
            PG8_STAGE(PG8_SB(0, 1), b2 + hstep, voffB);
            PG8_WAIT_V(6); PG8_BAR; PG8_MMA(1, 1, At, B1); PG8_BAR;
            PG8_LDB(B0, 1, 0); PG8_SCHED; PG8_LDA(At, 1, 0); PG8_STAGE(PG8_SA(0, 1), a2 + hstep, voffA);
            PG8_WAIT_L(8); PG8_BAR; PG8_WAIT_L(0); PG8_MMA(0, 0, At, B0); PG8_BAR; PG8_SCHED;
            PG8_LDB(B1, 1, 1); PG8_STAGE(PG8_SB(1, 0), b3, voffB);
            PG8_BAR; PG8_WAIT_L(0); PG8_MMA(0, 1, At, B1); PG8_BAR;
            PG8_LDA(At, 1, 1); PG8_STAGE(PG8_SA(1, 0), a3, voffA);
            PG8_BAR; PG8_WAIT_L(0); PG8_MMA(1, 0, At, B0); PG8_BAR; PG8_SCHED;
            PG8_STAGE(PG8_SB(1, 1), b3 + hstep, voffB);
            PG8_WAIT_V(6); PG8_BAR; PG8_MMA(1, 1, At, B1); PG8_BAR;
            }
        }
        if constexpr (ALIGN_EPI) { if (wr == 0) PG8_BAR; }
        if constexpr (!Epi::AFTER_DRAIN) { E(acc, cur, wr, wc, fr, fq); S.done(cur); }
        if (!has_next) break;
#pragma unroll
        for (int a = 0; a < 2; ++a)
#pragma unroll
            for (int b = 0; b < 2; ++b)
#pragma unroll
                for (int m = 0; m < 4; ++m)
#pragma unroll
                    for (int n = 0; n < 2; ++n) acc[a][b][m][n] = (f32x4){0.f, 0.f, 0.f, 0.f};
        cur = nxt; cA = nA; cB = nB; ++ui;
        if constexpr (ALIGN_EPI) { if (wr == 1) PG8_BAR; }
    }
    PG8_WAIT_V(0);
    if constexpr (!ALIGN_EPI) { if (wr == 0) PG8_BAR; }
    PG8_BAR;
    if constexpr (Epi::AFTER_DRAIN) { E.fused(acc, cur, wr, wc, fr, fq, lds, wid, lane); S.done(cur); }
#undef PG8_SA
#undef PG8_SB
#undef PG8_STAGE
#undef PG8_LDA
#undef PG8_LDB
#undef PG8_MMA
#undef PG8_WAIT_V
#undef PG8_WAIT_L
#undef PG8_BAR
#undef PG8_SCHED
}
}
namespace mk {
constexpr int NWAVES = 8;
constexpr int D = 1024, BATCH = 8, SEQ = 2048, M = BATCH * SEQ, DEPTH = 2, NQKV = 3072;
constexpr int DFF = 2816, NEXP = 8, DFE = 3584;
constexpr int TMAX = 136;
constexpr int PASS0_TILES = 64, HMOE_TILES = 72;
constexpr float LN_EPS = 1e-5f;
constexpr float ALPHA = 1.41421356237309515f;
constexpr float ROPE_THETA = 500000.0f;
constexpr float LOG2E = 1.4426950408889634f;

constexpr size_t MiB = 1u << 20;
constexpr size_t WS_CTL = 0, CTL_ZERO_BYTES = 1 * MiB;
constexpr size_t WS_TAB = 2 * MiB;
constexpr size_t WS_WMGU = 4 * MiB;
constexpr size_t WS_WMDN = WS_WMGU + 112 * MiB;
constexpr size_t WS_XBF = WS_WMDN + 56 * MiB;
constexpr size_t WS_R = WS_XBF + 32 * MiB;
constexpr size_t R_QKV = 0;
constexpr size_t R_O = 96 * MiB;
constexpr size_t R_MIX = 128 * MiB;
constexpr size_t R_H = 0;
constexpr size_t R_F = 96 * MiB;
constexpr size_t R_XS = 0;
constexpr size_t R_HM = 68 * MiB;
constexpr size_t R_WSMALL = 160 * MiB;
constexpr size_t R_WIN = R_WSMALL;
constexpr size_t R_WOUT = R_WIN + 12 * MiB;
constexpr size_t R_WGU = R_WOUT + 4 * MiB;
constexpr size_t R_WDN = R_WGU + 11 * MiB;
constexpr size_t R_SIZE = 194 * MiB;
constexpr size_t WS_END = WS_R + R_SIZE;
static_assert(R_WDN + (size_t)D * DFF * 2 <= R_SIZE && R_HM + (size_t)HMOE_TILES * 256 * DFE * 2 <= R_SIZE && (size_t)TMAX * 256 * D * 2 <= R_HM, "R map");
constexpr size_t T_ROPEA = 0;
constexpr size_t T_ROPEB = 64 * 1024;
constexpr size_t T_TOKE = 256 * 1024;
constexpr size_t T_TOKS = T_TOKE + 128 * 1024;
constexpr size_t T_TOKG = T_TOKS + 128 * 1024;
constexpr size_t T_TILEE = T_TOKG + 128 * 1024;
constexpr int CW_CNT = 1024;
constexpr int CW_BAR = 4096;

constexpr int RING_BYTES = 131072;
constexpr int MISC_OFF = RING_BYTES + 320;
constexpr int LDS_BYTES = 147456;

#define GAS __attribute__((address_space(1)))
#define LAS __attribute__((address_space(3)))
typedef unsigned short bf16;
typedef unsigned v4u __attribute__((ext_vector_type(4)));
typedef unsigned v2u __attribute__((ext_vector_type(2)));
typedef float f32x4 __attribute__((ext_vector_type(4)));
typedef float f32x16 __attribute__((ext_vector_type(16)));
typedef short bf16x8 __attribute__((ext_vector_type(8)));
typedef short s16x4 __attribute__((ext_vector_type(4)));
typedef GAS unsigned gu32;
#define RLX_AGENT __ATOMIC_RELAXED, __HIP_MEMORY_SCOPE_AGENT
#define LDS_WAIT() asm volatile("s_waitcnt lgkmcnt(0)" ::: "memory")
#define VM_WAIT() asm volatile("s_waitcnt vmcnt(0)" ::: "memory")
__device__ __forceinline__ unsigned f2bf(float f) { unsigned u = __builtin_bit_cast(unsigned, f); return (u + 0x7fffu + ((u >> 16) & 1u)) >> 16; }
__device__ __forceinline__ unsigned pk2(float lo, float hi) { return f2bf(lo) | (f2bf(hi) << 16); }
__device__ __forceinline__ float bflo(unsigned w) { return __builtin_bit_cast(float, w << 16); }
__device__ __forceinline__ float bfhi(unsigned w) { return __builtin_bit_cast(float, w & 0xffff0000u); }

#define XB_TMO      128
#define XB_XCNT(j)  (256  + 64 * (j))
#define XB_XSUB(j)  (1280 + 64 * (j))
#define XB_XGEN(j)  (2304 + 64 * (j))
#define XB_TOP      3328
#define XB_TOPGEN   3392
#define XCD_BAR_WORDS 3456
#define XB_SPIN_CAP (1u << 18)
__device__ __forceinline__ unsigned xb_ld(unsigned* p)              { return __hip_atomic_load(p, __ATOMIC_RELAXED, __HIP_MEMORY_SCOPE_AGENT); }
__device__ __forceinline__ unsigned xb_add(unsigned* p, unsigned v) { return __hip_atomic_fetch_add(p, v, __ATOMIC_RELAXED, __HIP_MEMORY_SCOPE_AGENT); }
__device__ __forceinline__ unsigned xb_xcc_id() { return (unsigned)__builtin_amdgcn_s_getreg((3 << 11) | 20) & 0xFu; }
#define XB_SPIN(cond, bar) do { unsigned _sp = 0; while (cond) { __builtin_amdgcn_s_sleep(1); \
    if ((++_sp & 255u) == 0u) { if (xb_ld(&(bar)[XB_TMO])) break; if (_sp > XB_SPIN_CAP) { atomicAdd(&(bar)[XB_TMO], 1u); break; } } } } while (0)
struct XcdBarrier { unsigned* bar; unsigned x; volatile LAS unsigned* st; };
__device__ __forceinline__ XcdBarrier xcd_barrier_post(unsigned* bar, volatile LAS unsigned* st) {
    XcdBarrier b; b.bar = bar; b.x = xb_xcc_id(); b.st = st;
    if (threadIdx.x == 0) (void)xb_add(&bar[XB_XCNT(b.x)], 1u);
    return b;
}
__device__ __forceinline__ void xcd_barrier_complete(unsigned* bar, unsigned x, unsigned& nloc, unsigned& nx) {
    const unsigned G = gridDim.x * gridDim.y * gridDim.z;
    unsigned sum, cnt, mine, sp = 0u;
    for (;;) {
        sum = 0u; cnt = 0u; mine = 0u;
#pragma unroll
        for (unsigned j = 0; j < 16; ++j) { const unsigned c = xb_ld(&bar[XB_XCNT(j)]); sum += c; cnt += (c > 0u) ? 1u : 0u; mine = (j == x) ? c : mine; }
        if (sum == G) break;
        __builtin_amdgcn_s_sleep(1);
        if ((++sp & 255u) == 0u) { if (xb_ld(&bar[XB_TMO])) break; if (sp > XB_SPIN_CAP) { atomicAdd(&bar[XB_TMO], 1u); break; } }
    }
    nloc = mine > 0u ? mine : 1u; nx = cnt > 0u ? cnt : 1u;
}
__device__ __forceinline__ void xcd_barrier(const XcdBarrier& b) {
    asm volatile("s_waitcnt vmcnt(0)" ::: "memory");
    __syncthreads();
    if (threadIdx.x == 0) {
        unsigned* bar = b.bar;
        __builtin_amdgcn_s_waitcnt(0);
        unsigned nloc = b.st[0], nx = b.st[1];
        if (nloc == 0u) { xcd_barrier_complete(bar, b.x, nloc, nx); b.st[0] = nloc; b.st[1] = nx; }
        const unsigned old = xb_add(&bar[XB_XSUB(b.x)], 1u);
        const unsigned gen = old / nloc;
        if (old + 1u == (gen + 1u) * nloc) {
            __builtin_amdgcn_fence(__ATOMIC_RELEASE, "agent");
            asm volatile("s_waitcnt vmcnt(0)" ::: "memory");
            const unsigned og = xb_add(&bar[XB_TOP], 1u);
            const unsigned tg = og / nx;
            if (og + 1u == (tg + 1u) * nx) xb_add(&bar[XB_TOPGEN], 1u);
            else XB_SPIN(xb_ld(&bar[XB_TOPGEN]) == tg, bar);
            __builtin_amdgcn_fence(__ATOMIC_ACQUIRE, "agent");
            xb_add(&bar[XB_XGEN(b.x)], 1u);
            asm volatile("s_waitcnt vmcnt(0)" ::: "memory");
        } else {
            XB_SPIN(xb_ld(&bar[XB_XGEN(b.x)]) == gen, bar);
            __builtin_amdgcn_fence(__ATOMIC_ACQUIRE, "agent");
            asm volatile("s_waitcnt vmcnt(0)" ::: "memory");
        }
    }
    __syncthreads();
}

__device__ __forceinline__ float wave_sum(float v) {
#pragma unroll
    for (int o = 1; o < 64; o <<= 1) v += __shfl_xor(v, o);
    return v;
}

__device__ __forceinline__ int map_row(int mode, int n) {
    if (mode == 1) { if (n >= 768 && n < 1536) { const int d = (n - 768) & 63; if (d >= 4 && d < 8) n += 4; else if (d >= 8 && d < 12) n -= 4; } return n; }
    if (mode == 2) return (n >> 7) * 256 + (n & 127);
    if (mode == 3) return (n >> 7) * 256 + 128 + (n & 127);
    return n;
}
__device__ __forceinline__ void transpose_item(const float* W, int K, int N, bf16* WT, int mode, const float* kscale, LAS float* scr, int item, int lane) {
    const int nblk = N / 32, kb = item / nblk, nb = item % nblk, k0 = 64 * kb, n0 = 32 * nb;
#pragma unroll 8
    for (int i = 0; i < 32; ++i) { const int kk = 2 * i + (lane >> 5); float v = W[(size_t)(k0 + kk) * N + n0 + (lane & 31)]; if (kscale) v *= kscale[k0 + kk]; scr[kk * 33 + (lane & 31)] = v; }
    LDS_WAIT(); asm volatile("" ::: "memory");
    const int c = lane & 7;
#pragma unroll
    for (int j = 0; j < 4; ++j) { const int n = (lane >> 3) + 8 * j; const LAS float* s = scr + (8 * c) * 33 + n;
        v4u o; o.x = pk2(s[0 * 33], s[1 * 33]); o.y = pk2(s[2 * 33], s[3 * 33]); o.z = pk2(s[4 * 33], s[5 * 33]); o.w = pk2(s[6 * 33], s[7 * 33]);
        *(GAS v4u*)(WT + (size_t)map_row(mode, n0 + n) * K + k0 + 8 * c) = o; }
    LDS_WAIT(); asm volatile("" ::: "memory");
}
template <int YMODE, bool ROUTER, bool WRITE_BF>
__device__ __forceinline__ void ln_phase(const float* resid, const bf16* Y0, const int* tok_pair, const float* tok_gate, const float* gam, const float* bet, float* out, bf16* xbf,
                                         const float* wr, gu32* cnt, int* tok_e, int* tok_s, float* tok_g, LAS unsigned char* L, int gw, int NGW, int lane) {
    int tidx = threadIdx.x; asm volatile("" : "+v"(lane), "+v"(tidx));
    LAS float* wrT = (LAS float*)L;
    if (ROUTER) { for (int i = tidx; i < D * NEXP; i += NWAVES * 64) wrT[(i & 7) * D + (i >> 3)] = wr[i]; __syncthreads(); }
    f32x4 gv[4], bv[4];
#pragma unroll
    for (int j = 0; j < 4; ++j) { gv[j] = *(const f32x4*)(gam + 4 * lane + 256 * j); bv[j] = *(const f32x4*)(bet + 4 * lane + 256 * j); }
    for (int m = gw; m < M; m += NGW) {
        const GAS f32x4* xr = (const GAS f32x4*)(resid + (size_t)m * D) + lane;
        f32x4 v[4]; float s = 0.f;
        if (YMODE == 0) {
            const GAS v2u* yr = (const GAS v2u*)(Y0 + (size_t)m * D) + lane;
#pragma unroll
            for (int j = 0; j < 4; ++j) { const f32x4 x = xr[64 * j]; const v2u w = yr[64 * j]; v[j].x = ALPHA * x.x + bflo(w.x); v[j].y = ALPHA * x.y + bfhi(w.x); v[j].z = ALPHA * x.z + bflo(w.y); v[j].w = ALPHA * x.w + bfhi(w.y); }
        } else {
            const int p0 = tok_pair[2 * m], p1 = tok_pair[2 * m + 1]; const float g0 = tok_gate[2 * m], g1 = tok_gate[2 * m + 1];
            const GAS v2u* y0 = (const GAS v2u*)(Y0 + (size_t)p0 * D) + lane; const GAS v2u* y1 = (const GAS v2u*)(Y0 + (size_t)p1 * D) + lane;
#pragma unroll
            for (int j = 0; j < 4; ++j) { const f32x4 x = xr[64 * j]; const v2u a = y0[64 * j], b = y1[64 * j];
                v[j].x = ALPHA * x.x + (g0 * bflo(a.x) + g1 * bflo(b.x)); v[j].y = ALPHA * x.y + (g0 * bfhi(a.x) + g1 * bfhi(b.x));
                v[j].z = ALPHA * x.z + (g0 * bflo(a.y) + g1 * bflo(b.y)); v[j].w = ALPHA * x.w + (g0 * bfhi(a.y) + g1 * bfhi(b.y)); }
        }
#pragma unroll
        for (int j = 0; j < 4; ++j) s += (v[j].x + v[j].y) + (v[j].z + v[j].w);
        const float mean = wave_sum(s) * (1.f / D); float s2 = 0.f;
#pragma unroll
        for (int j = 0; j < 4; ++j) { v[j] = v[j] - mean; s2 += (v[j].x * v[j].x + v[j].y * v[j].y) + (v[j].z * v[j].z + v[j].w * v[j].w); }
        const float rstd = 1.0f / sqrtf(wave_sum(s2) * (1.f / D) + LN_EPS);
        GAS f32x4* orow = (GAS f32x4*)(out + (size_t)m * D) + lane; GAS v2u* brow = (GAS v2u*)(xbf + (size_t)m * D) + lane;
#pragma unroll
        for (int j = 0; j < 4; ++j) { v[j] = v[j] * rstd * gv[j] + bv[j]; orow[64 * j] = v[j]; if (WRITE_BF) { v2u w; w.x = pk2(v[j].x, v[j].y); w.y = pk2(v[j].z, v[j].w); brow[64 * j] = w; } }
        if (ROUTER) {
            float lg[8];
#pragma unroll
            for (int e = 0; e < 8; ++e) { float a = 0.f;
#pragma unroll
                for (int j = 0; j < 4; ++j) { const f32x4 w = *(const LAS f32x4*)(wrT + e * D + 4 * lane + 256 * j); a += (v[j].x * w.x + v[j].y * w.y) + (v[j].z * w.z + v[j].w * w.w); }
                lg[e] = wave_sum(a); }
            int i0 = 0;
#pragma unroll
            for (int e = 1; e < 8; ++e) if (lg[e] > lg[i0]) i0 = e;
            int i1 = (i0 == 0) ? 1 : 0;
#pragma unroll
            for (int e = 0; e < 8; ++e) if (e != i0 && lg[e] > lg[i1]) i1 = e;
            if (lane == 0) {
                const float e1 = expf(lg[i1] - lg[i0]); const float g0 = 1.f / (1.f + e1), g1 = e1 / (1.f + e1);
                const int s0 = (int)__hip_atomic_fetch_add(cnt + i0, 1u, RLX_AGENT); const int s1 = (int)__hip_atomic_fetch_add(cnt + i1, 1u, RLX_AGENT);
                tok_e[2 * m] = i0; tok_e[2 * m + 1] = i1; tok_s[2 * m] = s0; tok_s[2 * m + 1] = s1; tok_g[2 * m] = g0; tok_g[2 * m + 1] = g1;
            }
        }
    }
}
__device__ __forceinline__ void moe_gather(const gu32* cnt, const int* tok_e, int* tok_s, const bf16* xbf, bf16* Xs, int* tile_e, LAS unsigned char* L, int gw, int NGW, int lane) {
    int tidx = threadIdx.x; asm volatile("" : "+v"(lane), "+v"(tidx));
    LAS int* lb = (LAS int*)L;
    if (tidx == 0) { int acc = 0; for (int e = 0; e < 8; ++e) { const int c = (int)cnt[e]; lb[e] = acc; lb[8 + e] = c; acc += (c + 255) & ~255; } lb[16] = acc >> 8; }
    __syncthreads();
    if (blockIdx.x == 0) { const int nt = lb[16]; for (int t = tidx; t < nt; t += NWAVES * 64) { int e = 0; for (int k = 1; k < 8; ++k) if (t * 256 >= lb[k]) e = k; tile_e[t] = e; } if (tidx == 0) tile_e[TMAX] = nt; }
    for (int m = gw; m < M; m += NGW) {
        const GAS v4u* src = (const GAS v4u*)(xbf + (size_t)m * D) + lane; const v4u a = src[0], b = src[64];
#pragma unroll
        for (int k = 0; k < 2; ++k) { const int e = tok_e[2 * m + k]; const int pr = lb[e] + tok_s[2 * m + k]; GAS v4u* dst = (GAS v4u*)(Xs + (size_t)pr * D) + lane; dst[0] = a; dst[64] = b; if (lane == 0) tok_s[2 * m + k] = pr; }
    }
    for (int e = 0; e < 8; ++e) { const int c = lb[8 + e], np = ((c + 255) & ~255) - c;
        for (int r = gw; r < np; r += NGW) { GAS v4u* dst = (GAS v4u*)(Xs + (size_t)(lb[e] + c + r) * D) + lane; dst[0] = (v4u){0u, 0u, 0u, 0u}; dst[64] = (v4u){0u, 0u, 0u, 0u}; } }
}
typedef short v4i16_t __attribute__((ext_vector_type(4)));
typedef float f32x2_t __attribute__((ext_vector_type(2))); typedef __bf16 bf16x2_t __attribute__((ext_vector_type(2)));
__device__ __forceinline__ int crow(int r, int hi) { return (r & 3) + 8 * (r >> 2) + 4 * hi; }
__device__ __forceinline__ unsigned cvtpk(float lo, float hi) { f32x2_t v = {lo, hi}; bf16x2_t b = __builtin_convertvector(v, bf16x2_t); return __builtin_bit_cast(unsigned, b); }
__device__ __forceinline__ float ex2(float x) { return __builtin_amdgcn_exp2f(x); }
__device__ __forceinline__ float xhalf(float x) { return __shfl_xor(x, 32); }
__device__ __forceinline__ bf16x8 vfrag(LAS unsigned char* p) {
    const v4i16_t lo = __builtin_amdgcn_ds_read_tr16_b64_v4i16((LAS v4i16_t*)p);
    const v4i16_t hi = __builtin_amdgcn_ds_read_tr16_b64_v4i16((LAS v4i16_t*)(p + 512));
    return (bf16x8){lo[0], lo[1], lo[2], lo[3], hi[0], hi[1], hi[2], hi[3]};
}
__device__ __forceinline__ bf16x8 pfrag(const unsigned* pw) { v4u t = {pw[0], pw[1], pw[2], pw[3]}; return __builtin_bit_cast(bf16x8, t); }
#define MFMA32(a, b, c) __builtin_amdgcn_mfma_f32_32x32x16_bf16((a), (b), (c), 0, 0, 0)

template <int NS>
__device__ __forceinline__ void softmax_update(f32x16 (&s)[NS], float& m, float& l, f32x16 (&O)[2], unsigned (&pw)[NS][8]) {
    float mx = s[0][0];
#pragma unroll
    for (int i = 0; i < NS; ++i)
#pragma unroll
        for (int r = 0; r < 16; ++r) mx = fmaxf(mx, s[i][r]);
    mx = fmaxf(mx, xhalf(mx));
    const float mn = fmaxf(m, mx);
    if (__any(mn > m)) { const float alpha = ex2(m - mn); l *= alpha;
#pragma unroll
        for (int d = 0; d < 2; ++d)
#pragma unroll
            for (int r = 0; r < 16; ++r) O[d][r] *= alpha; }
    m = mn;
    float rs = 0.f;
#pragma unroll
    for (int i = 0; i < NS; ++i) {
#pragma unroll
        for (int r = 0; r < 16; ++r) { s[i][r] = ex2(s[i][r] - mn); rs += s[i][r]; }
#pragma unroll
        for (int k = 0; k < 8; ++k) pw[i][k] = cvtpk(s[i][2 * k], s[i][2 * k + 1]);
    }
    l += rs;
}

constexpr int A_KBUF = 0, A_VBUF = 16384;
__device__ __forceinline__ void attn_a_unit(const bf16* QKV, bf16* Oout, int b, int h, int qblk, float lam, float lam_init, const float* ng, LAS unsigned char* L, int wave, int lane) {
    const int r32 = lane & 31, hi = lane >> 5;
    const size_t rowb = (size_t)b * SEQ;
    const bf16* qp = QKV + (rowb + qblk * 256 + wave * 32 + r32) * NQKV + h * 64 + 8 * hi;
    bf16x8 qf[2][2];
#pragma unroll
    for (int mp = 0; mp < 2; ++mp)
#pragma unroll
        for (int d0 = 0; d0 < 2; ++d0) qf[mp][d0] = *(const bf16x8*)(qp + 32 * mp + 16 * d0);
    const bf16* ksrc = QKV + (rowb + lane) * NQKV + 256 + h * 64 + wave * 8;
    const bf16* vsrc = QKV + (rowb + 16 * (wave & 3) + (lane >> 2)) * NQKV + 512 + h * 64 + 32 * (wave >> 2) + 8 * (lane & 3);
    LAS unsigned char* kdst = L + A_KBUF + wave * 1024 + lane * 16;
    LAS unsigned char* vdst = L + A_VBUF + wave * 1024 + lane * 16;
    LAS unsigned char* kfr = L + A_KBUF + hi * 1024 + r32 * 16;
    LAS unsigned char* vfr = L + A_VBUF + ((lane >> 4) & 1) * 32 + (lane & 3) * 8 + (4 * hi + ((lane & 15) >> 2)) * 64;
    f32x16 O[2][2]; float mrow[2], lrow[2];
#pragma unroll
    for (int mp = 0; mp < 2; ++mp) { mrow[mp] = -1e30f; lrow[mp] = 0.f;
#pragma unroll
        for (int d = 0; d < 2; ++d)
#pragma unroll
            for (int r = 0; r < 16; ++r) O[mp][d][r] = 0.f; }
    v4u kreg = *(const v4u*)ksrc, vreg = *(const v4u*)vsrc;
    *(LAS v4u*)kdst = kreg; *(LAS v4u*)vdst = vreg;
    __syncthreads();
    constexpr int NT = SEQ / 64;
    for (int t = 0; t < NT; ++t) {
        const int cur = (t & 1) * 8192, nxt = 8192 - cur;
        if (t + 1 < NT) { kreg = *(const v4u*)(ksrc + (size_t)(t + 1) * 64 * NQKV); vreg = *(const v4u*)(vsrc + (size_t)(t + 1) * 64 * NQKV); }
        unsigned pw[2][2][8];
#pragma unroll
        for (int mp = 0; mp < 2; ++mp) {
            f32x16 s[2];
#pragma unroll
            for (int r = 0; r < 16; ++r) { s[0][r] = 0.f; s[1][r] = 0.f; }
#pragma unroll
            for (int d0 = 0; d0 < 2; ++d0) {
                const bf16x8 k0 = *(LAS bf16x8*)(kfr + cur + (4 * mp + 2 * d0) * 1024), k1 = *(LAS bf16x8*)(kfr + cur + (4 * mp + 2 * d0) * 1024 + 512);
                s[0] = MFMA32(k0, qf[mp][d0], s[0]); s[1] = MFMA32(k1, qf[mp][d0], s[1]);
            }
            softmax_update<2>(s, mrow[mp], lrow[mp], O[mp], pw[mp]);
        }
#pragma unroll
        for (int ks = 0; ks < 4; ++ks)
#pragma unroll
            for (int d0 = 0; d0 < 2; ++d0) {
                const bf16x8 vf = vfrag(vfr + cur + d0 * 4096 + ks * 1024);
                O[0][d0] = MFMA32(vf, pfrag(&pw[0][ks >> 1][4 * (ks & 1)]), O[0][d0]);
                O[1][d0] = MFMA32(vf, pfrag(&pw[1][ks >> 1][4 * (ks & 1)]), O[1][d0]);
            }
        if (t + 1 < NT) { *(LAS v4u*)(kdst + nxt) = kreg; *(LAS v4u*)(vdst + nxt) = vreg; }
        __syncthreads();
    }
    const float i0 = 1.0f / (lrow[0] + xhalf(lrow[0])), i1 = lam / (lrow[1] + xhalf(lrow[1]));
    float ss = 0.f;
#pragma unroll
    for (int d = 0; d < 2; ++d)
#pragma unroll
        for (int r = 0; r < 16; ++r) { const float o = O[0][d][r] * i0 - O[1][d][r] * i1; O[0][d][r] = o; ss += o * o; }
    ss += xhalf(ss);
    const float rr = rsqrtf(ss * (1.0f / 64.0f) + LN_EPS) * (1.0f - lam_init);
    bf16* op = Oout + (rowb + qblk * 256 + wave * 32 + r32) * D + h * 64 + 4 * hi;
#pragma unroll
    for (int d = 0; d < 2; ++d)
#pragma unroll
        for (int g = 0; g < 4; ++g) { const f32x4 gg = *(const f32x4*)(ng + 32 * d + 8 * g + 4 * hi);
            v2u w; w.x = cvtpk(O[0][d][4 * g] * rr * gg.x, O[0][d][4 * g + 1] * rr * gg.y); w.y = cvtpk(O[0][d][4 * g + 2] * rr * gg.z, O[0][d][4 * g + 3] * rr * gg.w);
            *(v2u*)(op + 32 * d + 8 * g) = w; }
}

struct AttState { f32x16 O[2]; float m, l; };
template <class MaskFn>
__device__ __forceinline__ void block_step(AttState& st, const bf16x8 (&qf)[4], const bf16* kp, const bf16* vp0, const bf16* vp1, LAS unsigned char* vst, int lane, const MaskFn& mask) {
    const int hi = lane >> 5;
    bf16x8 kf[4];
#pragma unroll
    for (int d0 = 0; d0 < 4; ++d0) kf[d0] = *(const bf16x8*)(kp + 16 * d0);
    const v4u v00 = *(const v4u*)vp0, v01 = *(const v4u*)(vp0 + 32), v10 = *(const v4u*)vp1, v11 = *(const v4u*)(vp1 + 32);
    f32x16 s[1];
#pragma unroll
    for (int r = 0; r < 16; ++r) s[0][r] = 0.f;
#pragma unroll
    for (int d0 = 0; d0 < 4; ++d0) s[0] = MFMA32(kf[d0], qf[d0], s[0]);
#pragma unroll
    for (int r = 0; r < 16; ++r) s[0][r] = mask(r, s[0][r]);
    unsigned pw[1][8];
    softmax_update<1>(s, st.m, st.l, st.O, pw);
    *(LAS v4u*)(vst + 0 * 1024 + lane * 16) = v00; *(LAS v4u*)(vst + 1 * 1024 + lane * 16) = v10;
    *(LAS v4u*)(vst + 2 * 1024 + lane * 16) = v01; *(LAS v4u*)(vst + 3 * 1024 + lane * 16) = v11;
    LAS unsigned char* vfr = vst + ((lane >> 4) & 1) * 32 + (lane & 3) * 8 + (4 * hi + ((lane & 15) >> 2)) * 64;
#pragma unroll
    for (int ks = 0; ks < 2; ++ks)
#pragma unroll
        for (int d0 = 0; d0 < 2; ++d0) st.O[d0] = MFMA32(vfrag(vfr + (d0 * 2 + ks) * 1024), pfrag(&pw[0][4 * ks]), st.O[d0]);
}

constexpr int B_ST_O = 0, B_ST_ROW = 272, B_ST_M = 256 * 272, B_ST_L = B_ST_M + 1024, B_VST = 73728;
struct MaskB { int base; bool colok;
    __device__ __forceinline__ float operator()(int r, float s) const { const int dl = base + (r & 3) + 8 * (r >> 2); return (colok && (unsigned)(dl + 64) <= 128u) ? s : -INFINITY; } };
__device__ __forceinline__ void st_store(const AttState& st, LAS unsigned char* L, int ql, int hi, bool fin) {
    LAS float* row = (LAS float*)(L + B_ST_O + ql * B_ST_ROW);
#pragma unroll
    for (int d = 0; d < 2; ++d)
#pragma unroll
        for (int g = 0; g < 4; ++g) *(LAS f32x4*)(row + 32 * d + 8 * g + 4 * hi) = (f32x4){st.O[d][4 * g], st.O[d][4 * g + 1], st.O[d][4 * g + 2], st.O[d][4 * g + 3]};
    const float lt = st.l + xhalf(st.l);
    if (hi == 0) { ((LAS float*)(L + B_ST_M))[ql] = st.m; ((LAS float*)(L + B_ST_L))[ql] = lt; }
}
__device__ __forceinline__ void st_load(AttState& st, LAS unsigned char* L, int ql, int hi) {
    LAS float* row = (LAS float*)(L + B_ST_O + ql * B_ST_ROW);
#pragma unroll
    for (int d = 0; d < 2; ++d)
#pragma unroll
        for (int g = 0; g < 4; ++g) { const f32x4 v = *(LAS f32x4*)(row + 32 * d + 8 * g + 4 * hi); st.O[d][4 * g] = v.x; st.O[d][4 * g + 1] = v.y; st.O[d][4 * g + 2] = v.z; st.O[d][4 * g + 3] = v.w; }
    st.m = ((LAS float*)(L + B_ST_M))[ql]; st.l = hi == 0 ? ((LAS float*)(L + B_ST_L))[ql] : 0.f;
}
__device__ __forceinline__ void attn_b_unit(const bf16* QKV, bf16* Oout, int b, int h, int sp, LAS unsigned char* L, int wave, int lane) {
    const int r32 = lane & 31, hi = lane >> 5, c = r32;
    const size_t rowb = (size_t)b * SEQ; const int p0 = 256 * sp;
    const bf16* Qh = QKV + rowb * NQKV + 768 + h * 64; const bf16* Kh = QKV + rowb * NQKV + 1152 + h * 64; const bf16* Vh = QKV + rowb * NQKV + 1536 + h * 64;
    LAS unsigned char* vst = L + B_VST + wave * 4096;
    AttState st; bf16x8 qf[4];
    {   const int qpos = p0 + 32 * wave + c;
#pragma unroll
        for (int d0 = 0; d0 < 4; ++d0) qf[d0] = *(const bf16x8*)(Qh + (size_t)qpos * NQKV + 16 * d0 + 8 * hi);
        st.m = -1e30f; st.l = 0.f;
#pragma unroll
        for (int d = 0; d < 2; ++d)
#pragma unroll
            for (int r = 0; r < 16; ++r) st.O[d][r] = 0.f;
        for (int j = 0; j < 5; ++j) { const int k0 = p0 + 32 * wave - 64 + 32 * j; if (k0 < 0 || k0 >= SEQ) continue;
            MaskB mk{32 * j - 64 - c + 4 * hi, true};
            block_step(st, qf, Kh + (size_t)(k0 + r32) * NQKV + 8 * hi, Vh + (size_t)(k0 + (lane >> 2)) * NQKV + 8 * (lane & 3), Vh + (size_t)(k0 + 16 + (lane >> 2)) * NQKV + 8 * (lane & 3), vst, lane, mk); }
        st_store(st, L, 32 * wave + c, hi, false);
    }
    __syncthreads();
    {   const int rho = wave & 3, u = wave >> 2; const int ql = rho + 128 * u + 4 * c;
#pragma unroll
        for (int d0 = 0; d0 < 4; ++d0) qf[d0] = *(const bf16x8*)(Qh + (size_t)(p0 + ql) * NQKV + 16 * d0 + 8 * hi);
        st_load(st, L, ql, hi);
        const int mq0 = p0 / 4 + 32 * u;
        for (int j = 0; j < 5; ++j) { const int m0 = mq0 - 64 + 32 * j; if (m0 < 0 || m0 >= SEQ / 4) continue;
            MaskB mk{32 * j - 64 - c + 4 * hi, true};
            block_step(st, qf, Kh + (size_t)(rho + 4 * (m0 + r32)) * NQKV + 8 * hi, Vh + (size_t)(rho + 4 * (m0 + (lane >> 2))) * NQKV + 8 * (lane & 3), Vh + (size_t)(rho + 4 * (m0 + 16 + (lane >> 2))) * NQKV + 8 * (lane & 3), vst, lane, mk); }
        __syncthreads();
        st_store(st, L, ql, hi, false);
    }
    __syncthreads();
    {   const int rq = 2 * wave + (c >> 4), i = c & 15; const int ql = rq + 16 * i;
#pragma unroll
        for (int d0 = 0; d0 < 4; ++d0) qf[d0] = *(const bf16x8*)(Qh + (size_t)(p0 + ql) * NQKV + 16 * d0 + 8 * hi);
        st_load(st, L, ql, hi);
        const int mq0 = p0 / 16;
        for (int rb = 0; rb < 2; ++rb) { const int rho = 2 * wave + rb;
            for (int jb = 0; jb < 4; ++jb) { const int m0 = 32 * jb; if (m0 + 31 < mq0 - 64 || m0 > mq0 + 15 + 64) continue;
                MaskB mk{m0 - (mq0 + i) + 4 * hi, (c >> 4) == rb};
                block_step(st, qf, Kh + (size_t)(rho + 16 * (m0 + r32)) * NQKV + 8 * hi, Vh + (size_t)(rho + 16 * (m0 + (lane >> 2))) * NQKV + 8 * (lane & 3), Vh + (size_t)(rho + 16 * (m0 + 16 + (lane >> 2))) * NQKV + 8 * (lane & 3), vst, lane, mk); } }
        const float inv = 1.0f / (st.l + xhalf(st.l));
        bf16* op = Oout + (rowb + p0 + ql) * D + 256 + h * 64 + 4 * hi;
#pragma unroll
        for (int d = 0; d < 2; ++d)
#pragma unroll
            for (int g = 0; g < 4; ++g) { v2u w; w.x = cvtpk(st.O[d][4 * g] * inv, st.O[d][4 * g + 1] * inv); w.y = cvtpk(st.O[d][4 * g + 2] * inv, st.O[d][4 * g + 3] * inv); *(v2u*)(op + 32 * d + 8 * g) = w; }
    }
    __syncthreads();
}

constexpr int C_RPB = 110592;
struct MaskC1 { int cb, bb; const LAS float* rp;
    __device__ __forceinline__ float operator()(int r, float s) const { const int t = (r & 3) + 8 * (r >> 2); return ((unsigned)(cb + t) < 16u) ? s + rp[bb + t] : -INFINITY; } };
struct MaskC2 { int cb, bb; const LAS float* rp;
    __device__ __forceinline__ float operator()(int r, float s) const { const int t = (r & 3); return ((unsigned)(cb + t) < 16u) ? s + rp[bb + 31 * (r >> 2) + t] : -INFINITY; } };
__device__ __forceinline__ void attn_c_tile(const bf16* QKV, bf16* Oout, int b, int h, int grow, int half, LAS unsigned char* L, int wave, int lane) {
    const int r32 = lane & 31, hi = lane >> 5;
    const size_t rowb = (size_t)b * SEQ;
    const int c = 32 * half + r32, w0 = half ? 24 : 0;
    int rs = grow - 4; rs = rs < 0 ? 0 : (rs > 24 ? 24 : rs);
    int cs = c - 8; cs = cs < 0 ? 0 : (cs > 48 ? 48 : cs);
    const bf16* Qh = QKV + rowb * NQKV + 1920 + h * 64; const bf16* Kh = QKV + rowb * NQKV + 2304 + h * 64; const bf16* Vh = QKV + rowb * NQKV + 2688 + h * 64;
    LAS unsigned char* vst = L + B_VST + wave * 4096;
    const LAS float* rp = (const LAS float*)(L + C_RPB) + h * 15 * 31;
    AttState st; bf16x8 qf[4];
#pragma unroll
    for (int d0 = 0; d0 < 4; ++d0) qf[d0] = *(const bf16x8*)(Qh + (size_t)(grow * 64 + c) * NQKV + 16 * d0 + 8 * hi);
    st.m = -1e30f; st.l = 0.f;
#pragma unroll
    for (int d = 0; d < 2; ++d)
#pragma unroll
        for (int r = 0; r < 16; ++r) st.O[d][r] = 0.f;
    for (int j = 0; j < 8; ++j) { const int kr = rs + j; const int tok0 = kr * 64 + w0;
        MaskC1 mk{w0 + 4 * hi - cs, (kr - grow + 7) * 31 + (w0 + 4 * hi - c + 15), rp};
        block_step(st, qf, Kh + (size_t)(tok0 + r32) * NQKV + 8 * hi, Vh + (size_t)(tok0 + (lane >> 2)) * NQKV + 8 * (lane & 3), Vh + (size_t)(tok0 + 16 + (lane >> 2)) * NQKV + 8 * (lane & 3), vst, lane, mk); }
    for (int j = 0; j < 2; ++j) { const int kr0 = rs + 4 * j;
        MaskC2 mk{w0 + 32 + 4 * hi - cs, (kr0 - grow + 7) * 31 + (w0 + 32 + 4 * hi - c + 15), rp};
        const int kk = r32, k0 = lane >> 2, k1 = 16 + (lane >> 2);
        block_step(st, qf, Kh + (size_t)((kr0 + (kk >> 3)) * 64 + w0 + 32 + (kk & 7)) * NQKV + 8 * hi, Vh + (size_t)((kr0 + (k0 >> 3)) * 64 + w0 + 32 + (k0 & 7)) * NQKV + 8 * (lane & 3),
                   Vh + (size_t)((kr0 + (k1 >> 3)) * 64 + w0 + 32 + (k1 & 7)) * NQKV + 8 * (lane & 3), vst, lane, mk); }
    const float inv = 1.0f / (st.l + xhalf(st.l));
    bf16* op = Oout + (rowb + grow * 64 + c) * D + 640 + h * 64 + 4 * hi;
#pragma unroll
    for (int d = 0; d < 2; ++d)
#pragma unroll
        for (int g = 0; g < 4; ++g) { v2u w; w.x = cvtpk(st.O[d][4 * g] * inv, st.O[d][4 * g + 1] * inv); w.y = cvtpk(st.O[d][4 * g + 2] * inv, st.O[d][4 * g + 3] * inv); *(v2u*)(op + 32 * d + 8 * g) = w; }
}

__device__ __forceinline__ void attn_phase(const bf16* QKV, bf16* Oout, const float* lamp, const float* ng, const float* rpb, float lam_init, LAS unsigned char* L, int vcu, int G, int wave, int lane_in) {
    int lane = lane_in, tidx = threadIdx.x; asm volatile("" : "+v"(lane), "+v"(tidx));
    float s01 = 0.f, s23 = 0.f;
    for (int d = 0; d < 32; ++d) { s01 += lamp[d] * lamp[32 + d]; s23 += lamp[64 + d] * lamp[96 + d]; }
    const float lam = expf(s01) - expf(s23) + lam_init;
    for (int i = tidx; i < 6 * 15 * 31; i += NWAVES * 64) ((LAS float*)(L + C_RPB))[i] = rpb[i] * LOG2E;
    __syncthreads();
    for (int u = vcu; u < BATCH * 4 * 8; u += G) attn_a_unit(QKV, Oout, u >> 5, (u >> 3) & 3, u & 7, lam, lam_init, ng, L, wave, lane);
    __syncthreads();
    for (int uu = vcu; uu < 768; uu += G) {
        if (uu < 384) { attn_b_unit(QKV, Oout, uu / 48, (uu / 8) % 6, uu & 7, L, wave, lane); }
        else { const int id = uu - 384; attn_c_tile(QKV, Oout, id / 48, (id / 8) % 6, 4 * (id & 7) + (wave >> 1), wave & 1, L, wave, lane); }
    }
    __syncthreads();
}
struct Args { const float* in[18]; float* out; unsigned char* ws; int ph_lo, ph_hi; };
enum { I_X = 0, I_WIN, I_WOUT, I_BETA, I_LAMBDA, I_NORMG, I_RPB, I_LN1G, I_LN1B, I_LN2G, I_LN2B, I_FG, I_FU, I_FD, I_MR, I_MG, I_MU, I_MD };
constexpr int PH_PER_LAYER = 12, PH_END = 1 + 2 * PH_PER_LAYER;

__device__ __forceinline__ void prologue(const Args& args, LAS unsigned char* L, int gw, int NGW, int wave, int lane) {
    unsigned char* ws = args.ws;
    LAS float* scr = (LAS float*)(L + wave * 16384);
    int start = 0;
    for (int j = 0; j < 31; ++j) {
        const float* W; int K, N, mode; bf16* WT; const float* ks = nullptr;
        if (j < 4) { const int l = j >> 1;
            if ((j & 1) == 0) { W = args.in[I_WIN] + (size_t)l * D * NQKV; K = D; N = NQKV; mode = 1; WT = (bf16*)(ws + WS_R + R_WIN) + (size_t)l * NQKV * D; }
            else { W = args.in[I_WOUT] + (size_t)l * D * D; K = D; N = D; mode = 0; WT = (bf16*)(ws + WS_R + R_WOUT) + (size_t)l * D * D; ks = args.in[I_BETA] + l * D; } }
        else if (j < 7) {
            if (j == 4) { W = args.in[I_FG]; K = D; N = DFF; mode = 2; WT = (bf16*)(ws + WS_R + R_WGU); }
            else if (j == 5) { W = args.in[I_FU]; K = D; N = DFF; mode = 3; WT = (bf16*)(ws + WS_R + R_WGU); }
            else { W = args.in[I_FD]; K = DFF; N = D; mode = 0; WT = (bf16*)(ws + WS_R + R_WDN); } }
        else { const int e = (j - 7) / 3, kind = (j - 7) % 3;
            if (kind == 0) { W = args.in[I_MG] + (size_t)e * D * DFE; K = D; N = DFE; mode = 2; WT = (bf16*)(ws + WS_WMGU) + (size_t)e * 2 * DFE * D; }
            else if (kind == 1) { W = args.in[I_MU] + (size_t)e * D * DFE; K = D; N = DFE; mode = 3; WT = (bf16*)(ws + WS_WMGU) + (size_t)e * 2 * DFE * D; }
            else { W = args.in[I_MD] + (size_t)e * DFE * D; K = DFE; N = D; mode = 0; WT = (bf16*)(ws + WS_WMDN) + (size_t)e * D * DFE; } }
        const int nit = (K / 64) * (N / 32);
        const int first = (gw - (start % NGW) + NGW) % NGW;
        for (int it = first; it < nit; it += NGW) transpose_item(W, K, N, WT, mode, ks, scr, it, lane);
        start += nit;
    }
    { const float* x = args.in[I_X]; bf16* xbf = (bf16*)(ws + WS_XBF);
      for (int m = gw; m < M; m += NGW) { const GAS f32x4* xr = (const GAS f32x4*)(x + (size_t)m * D) + lane; GAS v2u* o = (GAS v2u*)(xbf + (size_t)m * D) + lane;
#pragma unroll
          for (int j = 0; j < 4; ++j) { const f32x4 v = xr[64 * j]; v2u w; w.x = pk2(v.x, v.y); w.y = pk2(v.z, v.w); o[64 * j] = w; } } }
    { float* ta = (float*)(ws + WS_TAB + T_ROPEA); float* tb = (float*)(ws + WS_TAB + T_ROPEB);
      for (int i = gw * 64 + lane; i < SEQ * 8; i += NGW * 64) {
          const int p = i >> 3, j = i & 7; const float invb = powf(ROPE_THETA, -(float)(2 * j) / 16.0f); const float angb = (float)p * invb;
          tb[p * 16 + j] = (float)cos((double)angb); tb[p * 16 + 8 + j] = (float)sin((double)angb);
          if (j < 4) { const float inva = powf(ROPE_THETA, -(float)(2 * j) / 8.0f); const float anga = (float)p * inva; ta[p * 8 + j] = (float)cos((double)anga); ta[p * 8 + 4 + j] = (float)sin((double)anga); } } }
}

__global__ void __launch_bounds__(NWAVES * 64, 2) mega(Args args) {
    extern __shared__ __attribute__((aligned(16))) unsigned char lds[];
    LAS unsigned char* L = (LAS unsigned char*)lds;
    volatile LAS unsigned* MISC = (volatile LAS unsigned*)(L + MISC_OFF);
    const int tid = threadIdx.x, lane = tid & 63, wave = __builtin_amdgcn_readfirstlane(tid >> 6);
    const int G = gridDim.x; const int bx = blockIdx.x;
    const int vcu = (G % 8 == 0) ? (bx % 8) * (G / 8) + bx / 8 : bx;
    const int gw = vcu * NWAVES + wave, NGW = G * NWAVES;
    unsigned char* ws = args.ws;
    gu32* ctl = (gu32*)(ws + WS_CTL);
    for (int u = tid; u < (LDS_BYTES - RING_BYTES) / 4; u += NWAVES * 64) ((LAS unsigned*)(L + RING_BYTES))[u] = 0u;
    __syncthreads();
    const int lo = args.ph_lo, hi = args.ph_hi;
    XcdBarrier bar; bar.bar = (unsigned*)(ctl + CW_BAR); bar.x = 0; bar.st = nullptr;
    if (hi - lo > 1) bar = xcd_barrier_post((unsigned*)(ctl + CW_BAR), MISC + 8);
#define IN(k) (lo <= (k) && (k) < hi)
#define SEAM(nextk) do { if ((nextk) < hi) xcd_barrier(bar); } while (0)
    bf16* XBF = (bf16*)(ws + WS_XBF);
    unsigned char* R = ws + WS_R;
    const float* ropeA = (const float*)(ws + WS_TAB + T_ROPEA); const float* ropeB = (const float*)(ws + WS_TAB + T_ROPEB);

    if (IN(0)) { prologue(args, L, gw, NGW, wave, lane); SEAM(1); }

    for (int l = 0; l < DEPTH; ++l) {
        const int pb = 1 + PH_PER_LAYER * l;
        if (hi <= pb || lo >= pb + PH_PER_LAYER) continue;
        if (IN(pb + 0)) {
            pg8::Gemm g{XBF, (const bf16*)(R + R_WIN) + (size_t)l * NQKV * D, M, NQKV, D}; pg8::StaticOrder S; S.init(M, NQKV, G, bx);
            pg8::EpiQKV E{(bf16*)(R + R_QKV), ropeA, ropeB};
            pg8::gemm_phase<pg8::EpiQKV, pg8::StaticOrder, true, true>(L, g, S, E);
            SEAM(pb + 1);
        }
        if (IN(pb + 1)) {
            attn_phase((const bf16*)(R + R_QKV), (bf16*)(R + R_O), args.in[I_LAMBDA] + l * 128, args.in[I_NORMG] + l * 64, args.in[I_RPB] + (size_t)l * 6 * 15 * 31,
                       0.8f - 0.6f * expf(-0.3f * (float)l), L, vcu, G, wave, lane);
            SEAM(pb + 2);
        }

        if (IN(pb + 2)) {
            pg8::Gemm g{(const bf16*)(R + R_O), (const bf16*)(R + R_WOUT) + (size_t)l * D * D, M, D, D}; pg8::StaticOrder S; S.init(M, D, G, bx);
            pg8::EpiStoreBf16 E{(bf16*)(R + R_MIX), D, 0, 1 << 20};
            pg8::gemm_phase<pg8::EpiStoreBf16, pg8::StaticOrder, true, true>(L, g, S, E);
            SEAM(pb + 3);
        }
        if (IN(pb + 3)) {
            const float* resid = (l == 0) ? args.in[I_X] : (const float*)args.out;
            if ((l & 1) == 0) ln_phase<0, false, true>(resid, (const bf16*)(R + R_MIX), nullptr, nullptr, args.in[I_LN1G] + l * D, args.in[I_LN1B] + l * D, args.out, XBF, nullptr, nullptr, nullptr, nullptr, nullptr, L, gw, NGW, lane);
            else ln_phase<0, true, true>(resid, (const bf16*)(R + R_MIX), nullptr, nullptr, args.in[I_LN1G] + l * D, args.in[I_LN1B] + l * D, args.out, XBF, args.in[I_MR] + (size_t)(l / 2) * D * NEXP, ctl + CW_CNT,
                                         (int*)(ws + WS_TAB + T_TOKE), (int*)(ws + WS_TAB + T_TOKS), (float*)(ws + WS_TAB + T_TOKG), L, gw, NGW, lane);
            SEAM(pb + 4);
        }

        if ((l & 1) == 0) {
            if (IN(pb + 4)) {
                pg8::Gemm g{XBF, (const bf16*)(R + R_WGU), M, 2 * DFF, D}; pg8::StaticOrder S; S.init(M, 2 * DFF, G, bx);
                pg8::EpiSwiglu E{(bf16*)(R + R_H), DFF, 0, 1 << 20};
                pg8::gemm_phase<pg8::EpiSwiglu, pg8::StaticOrder, true, true>(L, g, S, E);
                SEAM(pb + 5);
            }
            if (IN(pb + 5)) {
                pg8::Gemm g{(const bf16*)(R + R_H), (const bf16*)(R + R_WDN), M, D, DFF}; pg8::StaticOrder S; S.init(M, D, G, bx);
                pg8::EpiStoreBf16 E{(bf16*)(R + R_F), D, 0, 1 << 20};
                pg8::gemm_phase<pg8::EpiStoreBf16, pg8::StaticOrder, true, true>(L, g, S, E);
                SEAM(pb + 9);
            }
        } else {
            const bf16* WMGU = (const bf16*)(ws + WS_WMGU) + (size_t)(l / 2) * NEXP * 2 * DFE * D; const bf16* WMDN = (const bf16*)(ws + WS_WMDN) + (size_t)(l / 2) * NEXP * D * DFE;
            int* tile_e = (int*)(ws + WS_TAB + T_TILEE);
            if (IN(pb + 4)) {
                moe_gather(ctl + CW_CNT, (const int*)(ws + WS_TAB + T_TOKE), (int*)(ws + WS_TAB + T_TOKS), XBF, (bf16*)(R + R_XS), tile_e, L, gw, NGW, lane);
                SEAM(pb + 5);
            }
            for (int p = 0; p < 2; ++p) {
                if (!(IN(pb + 5 + 2 * p) || IN(pb + 6 + 2 * p))) continue;
                const int nt_all = __builtin_amdgcn_readfirstlane(tile_e[TMAX]);
                const int tile0 = p * PASS0_TILES; int nt = nt_all - tile0; nt = nt < 0 ? 0 : (nt > (p == 0 ? PASS0_TILES : HMOE_TILES) ? (p == 0 ? PASS0_TILES : HMOE_TILES) : nt);
                if (IN(pb + 5 + 2 * p)) {
                    pg8::Gemm g{(const bf16*)(R + R_XS), WMGU, 0, 0, D}; pg8::GroupedOrder S{nt, tile0, 2 * DFE / 256, G, bx, 0, tile_e};
                    pg8::EpiSwiglu E{(bf16*)(R + R_HM), DFE, -tile0, 2 * DFE / 256};
                    pg8::gemm_phase<pg8::EpiSwiglu, pg8::GroupedOrder, true, true>(L, g, S, E);
                    SEAM(pb + 6 + 2 * p);
                }
                if (IN(pb + 6 + 2 * p)) {
                    pg8::Gemm g{(const bf16*)(R + R_HM), WMDN, 0, 0, DFE}; pg8::GroupedOrder S{nt, tile0, D / 256, G, bx, 1, tile_e};
                    pg8::EpiStoreBf16 E{(bf16*)(R + R_XS), D, tile0, D / 256};
                    pg8::gemm_phase<pg8::EpiStoreBf16, pg8::GroupedOrder, true, true>(L, g, S, E);
                    SEAM(pb + 7 + 2 * p);
                }
            }

        }
        if (IN(pb + 9)) {
            if ((l & 1) == 0) ln_phase<0, false, true>(args.out, (const bf16*)(R + R_F), nullptr, nullptr, args.in[I_LN2G] + l * D, args.in[I_LN2B] + l * D, args.out, XBF, nullptr, nullptr, nullptr, nullptr, nullptr, L, gw, NGW, lane);
            else ln_phase<1, false, false>(args.out, (const bf16*)(R + R_XS), (const int*)(ws + WS_TAB + T_TOKS), (const float*)(ws + WS_TAB + T_TOKG), args.in[I_LN2G] + l * D, args.in[I_LN2B] + l * D, args.out, XBF,
                                           nullptr, nullptr, nullptr, nullptr, nullptr, L, gw, NGW, lane);
            SEAM(pb + PH_PER_LAYER);
        }

    }
#undef IN
#undef SEAM
}
}
extern "C" void kernel_launch(void* const* d_in, const int* in_sizes, int n_in, void* d_out, int out_size, void* d_ws, size_t ws_size, hipStream_t stream) {
    using namespace mk;
    static int grid = 0;
    if (grid == 0) {
        int dev = 0, cus = 0, per_cu = 0;
        if (n_in != 18 || out_size != M * D || ws_size < WS_END) { fprintf(stderr, "kernel_launch: unexpected problem (n_in %d, out %d, ws %zu < %zu)\n", n_in, out_size, ws_size, (size_t)WS_END); grid = -1; return; }
        if (hipGetDevice(&dev) != hipSuccess || hipDeviceGetAttribute(&cus, hipDeviceAttributeMultiprocessorCount, dev) != hipSuccess) { grid = -1; return; }
        if (hipFuncSetAttribute((const void*)mega, hipFuncAttributeMaxDynamicSharedMemorySize, LDS_BYTES) != hipSuccess) { fprintf(stderr, "kernel_launch: hipFuncSetAttribute failed\n"); grid = -1; return; }
        if (hipOccupancyMaxActiveBlocksPerMultiprocessor(&per_cu, (const void*)mega, NWAVES * 64, LDS_BYTES) != hipSuccess || per_cu < 1) { fprintf(stderr, "kernel_launch: occupancy query reports %d workgroups per CU\n", per_cu); }
        (void)hipGetLastError();
        grid = cus;
    }
    if (grid < 0) return;
    unsigned char* ws = (unsigned char*)d_ws;
    (void)hipMemsetAsync(ws + WS_CTL, 0, CTL_ZERO_BYTES, stream);
    Args a{};
    for (int i = 0; i < 18; ++i) a.in[i] = (const float*)d_in[i];
    a.out = (float*)d_out; a.ws = ws; a.ph_lo = 0; a.ph_hi = PH_END;
    hipLaunchKernelGGL(mega, dim3(grid), dim3(NWAVES * 64), LDS_BYTES, stream, a);
}
```

```cpp
#include <hip/hip_runtime.h>
#include <cstdio>
#include <cstdint>
#include <math.h>
#ifndef REP_PRO
#define REP_PRO 1
#endif
#ifndef REP_DENSE
#define REP_DENSE 1
#endif
#ifndef REP_MOEGU
#define REP_MOEGU 1
#endif
#ifndef REP_MOEDN
#define REP_MOEDN 1
#endif
#ifndef REP_ATTA
#define REP_ATTA 1
#endif
#ifndef REP_ATTBC
#define REP_ATTBC 1
#endif
#ifndef PROBE_THR
#define PROBE_THR 1e-4f
#endif
namespace pg8 {
#define PG8_LAS __attribute__((address_space(3)))
typedef unsigned short bf16_t;
typedef short bf16x8 __attribute__((ext_vector_type(8)));
typedef float f32x4 __attribute__((ext_vector_type(4)));
typedef unsigned u32x4 __attribute__((ext_vector_type(4)));
constexpr int BM = 256, BK = 64, HALF = 128, HTB = HALF * BK * 2  , STAGE_BYTES = 8 * HTB, NXCD = 8, WGM = 8;

__host__ __device__ __forceinline__ int lds_byte(int r, int c) { const int st = (r >> 4) * 2 + (c >> 5), rr = r & 15, cc = c & 31, ob = rr * 64 + cc * 2; return st * 1024 + (ob ^ (((ob >> 9) & 1) << 5)); }
__host__ __device__ __forceinline__ void stage_rc(int b, int& R, int& C) { const int st = b / 1024, sb = b % 1024, swz = sb ^ (((sb >> 9) & 1) << 5); R = (st >> 1) * 16 + swz / 64; C = (st & 1) * 32 + (swz % 64) / 2; }
__host__ __device__ __forceinline__ int perm32(int rho) { const int n = rho >> 4, i = rho & 15; return 8 * (i >> 2) + 4 * n + (i & 3); }

struct Unit { int pm, pn; };
struct Gemm { const bf16_t* A; const bf16_t* Bt; int M, N, K; };

struct StaticOrder {
    int nM, nN, nwg, G, c;
    __host__ __device__ void init(int M, int N, int G_, int c_) { nM = M / BM; nN = N / BM; nwg = nM * nN; G = G_; c = c_; }
    __host__ __device__ bool next(int i, Unit& u) const {
        const long L = (long)i * G + c; if (L >= nwg) return false;
        int wgid = (int)L; { const int q = nwg / NXCD, r = nwg % NXCD, xcd = wgid % NXCD, off = wgid / NXCD; wgid = (xcd < r ? xcd * (q + 1) : r * (q + 1) + (xcd - r) * q) + off; }
        const int nig = WGM * nN, gid = wgid / nig, fm = gid * WGM, gsz = (nM - fm) < WGM ? (nM - fm) : WGM;
        u.pm = fm + ((wgid % nig) % gsz); u.pn = (wgid % nig) / gsz; return true;
    }
    __device__ __forceinline__ void a_ready(const Unit&) const {}
    __device__ __forceinline__ void done(const Unit&) const {}
};

__device__ __forceinline__ unsigned cvt_pk_bf16(float lo, float hi) { unsigned r; asm volatile("v_cvt_pk_bf16_f32 %0, %1, %2" : "=v"(r) : "v"(lo), "v"(hi)); return r; }
typedef float f32x2 __attribute__((ext_vector_type(2)));
__device__ __forceinline__ f32x2 gelu_pk(f32x2 v) {
    const f32x2 av = __builtin_elementwise_abs(v), d = av * 0.2316418882f + 1.0f;
    f32x2 t; t.x = __builtin_amdgcn_rcpf(d.x); t.y = __builtin_amdgcn_rcpf(d.y);
    f32x2 q = t * 0.5307027145f + (-0.7265760135f); q = q * t + 0.7107068705f; q = q * t + (-0.142248368f); q = q * t + 0.127414796f; q = q * t;
    const f32x2 s = (v * v) * (-0.72134752044f);
    f32x2 e; e.x = __builtin_amdgcn_exp2f(s.x); e.y = __builtin_amdgcn_exp2f(s.y);
    const f32x2 m = v * (q * e), r = v - m;
    f32x2 o; o.x = v.x < 0.f ? m.x : r.x; o.y = v.y < 0.f ? m.y : r.y; return o;
}

constexpr float LOG2E = 1.4426950408889634f;
constexpr float QSCALE_A = 0.17677669529663687f * LOG2E;
constexpr float QSCALE_BC = 0.125f * LOG2E;
struct EpiQKV {
    static constexpr bool PERM = true, AFTER_DRAIN = false;
    bf16_t* O; const float* ropeA; const float* ropeB;
    __device__ __forceinline__ void operator()(const f32x4 (&acc)[2][2][4][2], const Unit& u, int wr, int wc, int fr, int fq) const {
        const int row0 = u.pm * BM + wr * 64 + fr;
#pragma unroll
        for (int bj = 0; bj < 2; ++bj) {
            const int c0 = u.pn * BM + bj * HALF + wc * 32 + 8 * fq;
            int mode = 0, j0 = 0; float sc = 1.f;
            if (c0 < 512) { if ((c0 & 31) == 0) mode = 1; if (c0 < 256) sc = QSCALE_A; }
            else if (c0 >= 768 && c0 < 1536) { const int ho = (c0 - 768) & 63; if (ho == 0) { mode = 2; j0 = 0; } else if (ho == 8) { mode = 2; j0 = 4; } if (c0 < 1152) sc = QSCALE_BC; }
            else if (c0 >= 1920 && c0 < 2304) sc = QSCALE_BC;
#pragma unroll
            for (int ai = 0; ai < 2; ++ai)
#pragma unroll
                for (int m = 0; m < 4; ++m) {
                    const int row = row0 + ai * HALF + m * 16; const int pos = row & 2047;
                    f32x4 v0 = acc[ai][bj][m][0], v1 = acc[ai][bj][m][1];
                    if (mode == 1) { const f32x4 c = *(const f32x4*)(ropeA + pos * 8), s = *(const f32x4*)(ropeA + pos * 8 + 4); const f32x4 a = v0 * c - v1 * s, b = v1 * c + v0 * s; v0 = a; v1 = b; }
                    else if (mode == 2) { const f32x4 c = *(const f32x4*)(ropeB + pos * 16 + j0), s = *(const f32x4*)(ropeB + pos * 16 + 8 + j0); const f32x4 a = v0 * c - v1 * s, b = v1 * c + v0 * s; v0 = a; v1 = b; }
                    v0 = v0 * sc; v1 = v1 * sc;
                    u32x4 w; w.x = cvt_pk_bf16(v0[0], v0[1]); w.y = cvt_pk_bf16(v0[2], v0[3]); w.z = cvt_pk_bf16(v1[0], v1[1]); w.w = cvt_pk_bf16(v1[2], v1[3]);
                    *(u32x4*)(O + (size_t)row * 3072 + c0) = w;
                }
        }
    }
};
struct EpiStoreBf16 {
    static constexpr bool PERM = true, AFTER_DRAIN = false;
    bf16_t* O; int ldc; int pm_off; int pn_mod;
    __device__ __forceinline__ void operator()(const f32x4 (&acc)[2][2][4][2], const Unit& u, int wr, int wc, int fr, int fq) const {
        const int row0 = (u.pm + pm_off) * BM + wr * 64 + fr; const int col0 = (u.pn % pn_mod) * BM + wc * 32 + 8 * fq;
#pragma unroll
        for (int ai = 0; ai < 2; ++ai)
#pragma unroll
            for (int m = 0; m < 4; ++m) { bf16_t* rowp = O + (size_t)(row0 + ai * HALF + m * 16) * ldc + col0;
#pragma unroll
                for (int bj = 0; bj < 2; ++bj) { const f32x4 v0 = acc[ai][bj][m][0], v1 = acc[ai][bj][m][1];
                    u32x4 w; w.x = cvt_pk_bf16(v0[0], v0[1]); w.y = cvt_pk_bf16(v0[2], v0[3]); w.z = cvt_pk_bf16(v1[0], v1[1]); w.w = cvt_pk_bf16(v1[2], v1[3]);
                    *(u32x4*)(rowp + bj * HALF) = w; } }
    }
};
struct EpiSwiglu {
    static constexpr bool PERM = true, AFTER_DRAIN = false;
    bf16_t* O; int ldc; int pm_off; int pn_mod;
    __device__ __forceinline__ void operator()(const f32x4 (&acc)[2][2][4][2], const Unit& u, int wr, int wc, int fr, int fq) const {
        const int row0 = (u.pm + pm_off) * BM + wr * 64 + fr; const int col0 = (u.pn % pn_mod) * HALF + wc * 32 + 8 * fq;
#pragma unroll
        for (int ai = 0; ai < 2; ++ai)
#pragma unroll
            for (int m = 0; m < 4; ++m) {
                float h[8];
#pragma unroll
                for (int n = 0; n < 2; ++n)
#pragma unroll
                    for (int j = 0; j < 4; ++j) { const float g = acc[ai][0][m][n][j], up = acc[ai][1][m][n][j];
                        const float e = __builtin_amdgcn_exp2f(-g * LOG2E); h[n * 4 + j] = g * __builtin_amdgcn_rcpf(1.0f + e) * up; }
                u32x4 w; w.x = cvt_pk_bf16(h[0], h[1]); w.y = cvt_pk_bf16(h[2], h[3]); w.z = cvt_pk_bf16(h[4], h[5]); w.w = cvt_pk_bf16(h[6], h[7]);
                *(u32x4*)(O + (size_t)(row0 + ai * HALF + m * 16) * ldc + col0) = w;
            }
    }
};
struct GroupedOrder {
    int ntiles, tile0, NP, G, c, a_rel; const int* tile_expert;
    __device__ __forceinline__ bool next(int i, Unit& u) const {
        const long L = (long)i * G + c; if (L >= (long)ntiles * NP) return false;
        const int g = (int)(L / (8 * NP)), r = (int)(L % (8 * NP)); const int rem = ntiles - 8 * g, gsz = rem < 8 ? rem : 8;
        const int pnl = r / gsz, t = 8 * g + (r % gsz);
        const int e = __builtin_amdgcn_readfirstlane(tile_expert[tile0 + t]);
        u.pm = a_rel ? t : tile0 + t; u.pn = e * NP + pnl; return true;
    }
    __device__ __forceinline__ void a_ready(const Unit&) const {}
    __device__ __forceinline__ void done(const Unit&) const {}
};
template <class Epi, class Sched, bool ALIGN_EPI = false, bool SP2 = false>
__device__ __forceinline__ void gemm_phase(PG8_LAS unsigned char* lds, const Gemm g, const Sched& S, const Epi& E) {
    int tid_ = threadIdx.x; asm volatile("" : "+v"(tid_));
    const int tid = tid_, wid = __builtin_amdgcn_readfirstlane(tid >> 6), lane = tid & 63, wr = wid >> 2, wc = wid & 3, fr = lane & 15, fq = lane >> 4;
    const int K = g.K, nt = K / BK;
    unsigned voffA[2], voffB[2];
#pragma unroll
    for (int i = 0; i < 2; ++i) { int R, C; stage_rc(tid * 16 + i * 8192, R, C); const int Rb = Epi::PERM ? ((R & ~31) + perm32(R & 31)) : R;
        voffA[i] = (unsigned)(R * K + C) * 2u; voffB[i] = (unsigned)(Rb * K + C) * 2u; }
    const size_t kstep = (size_t)(BK * 2);
    const size_t hstep = (size_t)HALF * K * 2;
    const size_t tstep = 2 * hstep;
    const unsigned ldsw = (unsigned)wid * 1024u;
    const int aoff = lds_byte(wr * 64 + fr, fq * 8), boff = lds_byte(wc * 32 + fr, fq * 8);
#define PG8_SA(b, h) (((b) * 2 + (h)) * HTB)
#define PG8_SB(b, h) ((4 + (b) * 2 + (h)) * HTB)
#define PG8_STAGE(bufoff, gbase, voff) do { _Pragma("unroll") for (int _i = 0; _i < 2; ++_i) \
        __builtin_amdgcn_global_load_lds((const unsigned*)((const char*)(gbase) + (voff)[_i]), (PG8_LAS unsigned*)(lds + (bufoff) + ldsw + _i * 8192), 16, 0, 0); } while (0)
#define PG8_LDA(dst, b, h) do { _Pragma("unroll") for (int m = 0; m < 4; ++m) _Pragma("unroll") for (int k = 0; k < 2; ++k) dst[m][k] = *(const PG8_LAS bf16x8*)(lds + PG8_SA(b, h) + aoff + m * 2048 + k * 1024); } while (0)
#define PG8_LDB(dst, b, h) do { _Pragma("unroll") for (int n = 0; n < 2; ++n) _Pragma("unroll") for (int k = 0; k < 2; ++k) dst[n][k] = *(const PG8_LAS bf16x8*)(lds + PG8_SB(b, h) + boff + n * 2048 + k * 1024); } while (0)
#define PG8_MMA(ai, bj, At, Bt) do { __builtin_amdgcn_s_setprio(1); _Pragma("unroll") for (int m = 0; m < 4; ++m) _Pragma("unroll") for (int n = 0; n < 2; ++n) _Pragma("unroll") for (int k = 0; k < 2; ++k) \
        acc[ai][bj][m][n] = __builtin_amdgcn_mfma_f32_16x16x32_bf16(Bt[n][k], At[m][k], acc[ai][bj][m][n], 0, 0, 0); __builtin_amdgcn_s_setprio(0); } while (0)
#define PG8_WAIT_V(n) asm volatile("s_waitcnt vmcnt(" #n ")" ::: "memory")
#define PG8_WAIT_L(n) asm volatile("s_waitcnt lgkmcnt(" #n ")" ::: "memory")
#define PG8_BAR __builtin_amdgcn_s_barrier()
#define PG8_SCHED __builtin_amdgcn_sched_barrier(0)
    Unit cur, nxt; int ui = 0;
    if (!S.next(0, cur)) return;
    f32x4 acc[2][2][4][2];
#pragma unroll
    for (int a = 0; a < 2; ++a)
#pragma unroll
        for (int b = 0; b < 2; ++b)
#pragma unroll
            for (int m = 0; m < 4; ++m)
#pragma unroll
                for (int n = 0; n < 2; ++n) acc[a][b][m][n] = (f32x4){0.f, 0.f, 0.f, 0.f};
    bf16x8 At[4][2], B0[2][2], B1[2][2];
    const char* cA = (const char*)g.A + (size_t)cur.pm * tstep; const char* cB = (const char*)g.Bt + (size_t)cur.pn * tstep;
    S.a_ready(cur);
    if constexpr (SP2) {
        PG8_STAGE(PG8_SB(0, 0), cB, voffB); PG8_STAGE(PG8_SB(0, 1), cB + hstep, voffB); PG8_STAGE(PG8_SA(0, 0), cA, voffA); PG8_STAGE(PG8_SA(0, 1), cA + hstep, voffA);
        if (wr == 1) PG8_BAR;
        PG8_WAIT_V(2); PG8_BAR;
        PG8_STAGE(PG8_SB(1, 0), cB + kstep, voffB); PG8_STAGE(PG8_SA(1, 0), cA + kstep, voffA); PG8_STAGE(PG8_SB(1, 1), cB + hstep + kstep, voffB);
        PG8_WAIT_V(6); PG8_BAR;
    } else {
        PG8_STAGE(PG8_SB(0, 0), cB, voffB); PG8_STAGE(PG8_SA(0, 0), cA, voffA); PG8_STAGE(PG8_SB(0, 1), cB + hstep, voffB); PG8_STAGE(PG8_SA(0, 1), cA + hstep, voffA);
        if (wr == 1) PG8_BAR;
        PG8_WAIT_V(4); PG8_BAR;
        PG8_STAGE(PG8_SB(1, 0), cB + kstep, voffB); PG8_STAGE(PG8_SA(1, 0), cA + kstep, voffA); PG8_STAGE(PG8_SB(1, 1), cB + hstep + kstep, voffB);
        PG8_WAIT_V(6); PG8_BAR;
    }
    for (;;) {
        const bool has_next = S.next(ui + 1, nxt);
        const char* nA = has_next ? (const char*)g.A + (size_t)nxt.pm * tstep : cA; const char* nB = has_next ? (const char*)g.Bt + (size_t)nxt.pn * tstep : cB;
        for (int t = 0; t < nt; t += 2) {
            const bool last = (t == nt - 2);
            const char* a1 = cA + (size_t)(t + 1) * kstep;
            const char* a2 = last ? nA : cA + (size_t)(t + 2) * kstep; const char* b2 = last ? nB : cB + (size_t)(t + 2) * kstep;
            const char* a3 = a2 + kstep; const char* b3 = b2 + kstep;
            if (last && has_next) S.a_ready(nxt);
            if constexpr (SP2) {
            PG8_LDB(B0, 0, 0); PG8_LDB(B1, 0, 1); PG8_SCHED; PG8_LDA(At, 0, 0); PG8_STAGE(PG8_SA(1, 1), a1 + hstep, voffA);
            PG8_WAIT_V(8); PG8_WAIT_L(0); PG8_BAR; PG8_MMA(0, 0, At, B0); PG8_MMA(0, 1, At, B1); PG8_BAR; PG8_SCHED;
            PG8_LDA(At, 0, 1); PG8_STAGE(PG8_SB(0, 0), b2, voffB); PG8_STAGE(PG8_SB(0, 1), b2 + hstep, voffB); PG8_STAGE(PG8_SA(0, 0), a2, voffA);
            PG8_WAIT_V(8); PG8_WAIT_L(0); PG8_BAR; PG8_MMA(1, 0, At, B0); PG8_MMA(1, 1, At, B1); PG8_BAR; PG8_SCHED;
            PG8_LDB(B0, 1, 0); PG8_LDB(B1, 1, 1); PG8_SCHED; PG8_LDA(At, 1, 0); PG8_STAGE(PG8_SA(0, 1), a2 + hstep, voffA);
            PG8_WAIT_V(8); PG8_WAIT_L(0); PG8_BAR; PG8_MMA(0, 0, At, B0); PG8_MMA(0, 1, At, B1); PG8_BAR; PG8_SCHED;
            PG8_LDA(At, 1, 1); PG8_STAGE(PG8_SB(1, 0), b3, voffB); PG8_STAGE(PG8_SB(1, 1), b3 + hstep, voffB); PG8_STAGE(PG8_SA(1, 0), a3, voffA);
            PG8_WAIT_V(8); PG8_WAIT_L(0); PG8_BAR; PG8_MMA(1, 0, At, B0); PG8_MMA(1, 1, At, B1); PG8_BAR; PG8_SCHED;
            } else {
            PG8_LDB(B0, 0, 0); PG8_SCHED; PG8_LDA(At, 0, 0); PG8_STAGE(PG8_SA(1, 1), a1 + hstep, voffA);
            PG8_WAIT_L(8); PG8_BAR; PG8_WAIT_L(0); PG8_MMA(0, 0, At, B0); PG8_BAR; PG8_SCHED;
            PG8_LDB(B1, 0, 1); PG8_STAGE(PG8_SB(0, 0), b2, voffB);
            PG8_BAR; PG8_WAIT_L(0); PG8_MMA(0, 1, At, B1); PG8_BAR;
            PG8_LDA(At, 0, 1); PG8_STAGE(PG8_SA(0, 0), a2, voffA);
            PG8_BAR; PG8_WAIT_L(0); PG8_MMA(1, 0, At, B0); PG8_BAR; PG8_SCHED;
            PG8_STAGE(PG8_SB(0, 1), b2 + hstep, voffB);
            PG8_WAIT_V(6); PG8_BAR; PG8_MMA(1, 1, At, B1); PG8_BAR;
            PG8_LDB(B0, 1, 0); PG8_SCHED; PG8_LDA(At, 1, 0); PG8_STAGE(PG8_SA(0, 1), a2 + hstep, voffA);
            PG8_WAIT_L(8); PG8_BAR; PG8_WAIT_L(0); PG8_MMA(0, 0, At, B0); PG8_BAR; PG8_SCHED;
            PG8_LDB(B1, 1, 1); PG8_STAGE(PG8_SB(1, 0), b3, voffB);
            PG8_BAR; PG8_WAIT_L(0); PG8_MMA(0, 1, At, B1); PG8_BAR;
            PG8_LDA(At, 1, 1); PG8_STAGE(PG8_SA(1, 0), a3, voffA);
            PG8_BAR; PG8_WAIT_L(0); PG8_MMA(1, 0, At, B0); PG8_BAR; PG8_SCHED;
            PG8_STAGE(PG8_SB(1, 1), b3 + hstep, voffB);
            PG8_WAIT_V(6); PG8_BAR; PG8_MMA(1, 1, At, B1); PG8_BAR;
            }
        }
        if constexpr (ALIGN_EPI) { if (wr == 0) PG8_BAR; }
        if constexpr (!Epi::AFTER_DRAIN) { E(acc, cur, wr, wc, fr, fq); S.done(cur); }
        if (!has_next) break;
#pragma unroll
        for (int a = 0; a < 2; ++a)
#pragma unroll
            for (int b = 0; b < 2; ++b)
#pragma unroll
                for (int m = 0; m < 4; ++m)
#pragma unroll
                    for (int n = 0; n < 2; ++n) acc[a][b][m][n] = (f32x4){0.f, 0.f, 0.f, 0.f};
        cur = nxt; cA = nA; cB = nB; ++ui;
        if constexpr (ALIGN_EPI) { if (wr == 1) PG8_BAR; }
    }
    PG8_WAIT_V(0);
    if constexpr (!ALIGN_EPI) { if (wr == 0) PG8_BAR; }
    PG8_BAR;
    if constexpr (Epi::AFTER_DRAIN) { E.fused(acc, cur, wr, wc, fr, fq, lds, wid, lane); S.done(cur); }
#undef PG8_SA
#undef PG8_SB
#undef PG8_STAGE
#undef PG8_LDA
#undef PG8_LDB
#undef PG8_MMA
#undef PG8_WAIT_V
#undef PG8_WAIT_L
#undef PG8_BAR
#undef PG8_SCHED
}
}
namespace mk {
constexpr int NWAVES = 8;
constexpr int D = 1024, BATCH = 8, SEQ = 2048, M = BATCH * SEQ, DEPTH = 2, NQKV = 3072;
constexpr int DFF = 2816, NEXP = 8, DFE = 3584;
constexpr int TMAX = 136;
constexpr int PASS0_TILES = 64, HMOE_TILES = 72;
constexpr float LN_EPS = 1e-5f;
constexpr float ALPHA = 1.41421356237309515f;
constexpr float ROPE_THETA = 500000.0f;
constexpr float LOG2E = 1.4426950408889634f;

constexpr size_t MiB = 1u << 20;
constexpr size_t WS_CTL = 0, CTL_ZERO_BYTES = 1 * MiB;
constexpr size_t WS_TAB = 2 * MiB;
constexpr size_t WS_WMGU = 4 * MiB;
constexpr size_t WS_WMDN = WS_WMGU + 112 * MiB;
constexpr size_t WS_XBF = WS_WMDN + 56 * MiB;
constexpr size_t WS_R = WS_XBF + 32 * MiB;
constexpr size_t R_QKV = 0;
constexpr size_t R_O = 96 * MiB;
constexpr size_t R_MIX = 128 * MiB;
constexpr size_t R_H = 0;
constexpr size_t R_F = 96 * MiB;
constexpr size_t R_XS = 0;
constexpr size_t R_HM = 68 * MiB;
constexpr size_t R_WSMALL = 160 * MiB;
constexpr size_t R_WIN = R_WSMALL;
constexpr size_t R_WOUT = R_WIN + 12 * MiB;
constexpr size_t R_WGU = R_WOUT + 4 * MiB;
constexpr size_t R_WDN = R_WGU + 11 * MiB;
constexpr size_t R_SIZE = 194 * MiB;
constexpr size_t WS_END = WS_R + R_SIZE;
static_assert(R_WDN + (size_t)D * DFF * 2 <= R_SIZE && R_HM + (size_t)HMOE_TILES * 256 * DFE * 2 <= R_SIZE && (size_t)TMAX * 256 * D * 2 <= R_HM, "R map");
constexpr size_t T_ROPEA = 0;
constexpr size_t T_ROPEB = 64 * 1024;
constexpr size_t T_TOKE = 256 * 1024;
constexpr size_t T_TOKS = T_TOKE + 128 * 1024;
constexpr size_t T_TOKG = T_TOKS + 128 * 1024;
constexpr size_t T_TILEE = T_TOKG + 128 * 1024;
constexpr int CW_CNT = 1024;
constexpr int CW_BAR = 4096;

constexpr int RING_BYTES = 131072;
constexpr int MISC_OFF = RING_BYTES + 320;
constexpr int LDS_BYTES = 147456;

#define GAS __attribute__((address_space(1)))
#define LAS __attribute__((address_space(3)))
typedef unsigned short bf16;
typedef unsigned v4u __attribute__((ext_vector_type(4)));
typedef unsigned v2u __attribute__((ext_vector_type(2)));
typedef float f32x4 __attribute__((ext_vector_type(4)));
typedef float f32x16 __attribute__((ext_vector_type(16)));
typedef short bf16x8 __attribute__((ext_vector_type(8)));
typedef short s16x4 __attribute__((ext_vector_type(4)));
typedef GAS unsigned gu32;
#define RLX_AGENT __ATOMIC_RELAXED, __HIP_MEMORY_SCOPE_AGENT
#define LDS_WAIT() asm volatile("s_waitcnt lgkmcnt(0)" ::: "memory")
#define VM_WAIT() asm volatile("s_waitcnt vmcnt(0)" ::: "memory")
__device__ __forceinline__ unsigned f2bf(float f) { unsigned u = __builtin_bit_cast(unsigned, f); return (u + 0x7fffu + ((u >> 16) & 1u)) >> 16; }
__device__ __forceinline__ unsigned pk2(float lo, float hi) { return f2bf(lo) | (f2bf(hi) << 16); }
__device__ __forceinline__ float bflo(unsigned w) { return __builtin_bit_cast(float, w << 16); }
__device__ __forceinline__ float bfhi(unsigned w) { return __builtin_bit_cast(float, w & 0xffff0000u); }

#define XB_TMO      128
#define XB_XCNT(j)  (256  + 64 * (j))
#define XB_XSUB(j)  (1280 + 64 * (j))
#define XB_XGEN(j)  (2304 + 64 * (j))
#define XB_TOP      3328
#define XB_TOPGEN   3392
#define XCD_BAR_WORDS 3456
#define XB_SPIN_CAP (1u << 18)
__device__ __forceinline__ unsigned xb_ld(unsigned* p)              { return __hip_atomic_load(p, __ATOMIC_RELAXED, __HIP_MEMORY_SCOPE_AGENT); }
__device__ __forceinline__ unsigned xb_add(unsigned* p, unsigned v) { return __hip_atomic_fetch_add(p, v, __ATOMIC_RELAXED, __HIP_MEMORY_SCOPE_AGENT); }
__device__ __forceinline__ unsigned xb_xcc_id() { return (unsigned)__builtin_amdgcn_s_getreg((3 << 11) | 20) & 0xFu; }
#define XB_SPIN(cond, bar) do { unsigned _sp = 0; while (cond) { __builtin_amdgcn_s_sleep(1); \
    if ((++_sp & 255u) == 0u) { if (xb_ld(&(bar)[XB_TMO])) break; if (_sp > XB_SPIN_CAP) { atomicAdd(&(bar)[XB_TMO], 1u); break; } } } } while (0)
struct XcdBarrier { unsigned* bar; unsigned x; volatile LAS unsigned* st; };
__device__ __forceinline__ XcdBarrier xcd_barrier_post(unsigned* bar, volatile LAS unsigned* st) {
    XcdBarrier b; b.bar = bar; b.x = xb_xcc_id(); b.st = st;
    if (threadIdx.x == 0) (void)xb_add(&bar[XB_XCNT(b.x)], 1u);
    return b;
}
__device__ __forceinline__ void xcd_barrier_complete(unsigned* bar, unsigned x, unsigned& nloc, unsigned& nx) {
    const unsigned G = gridDim.x * gridDim.y * gridDim.z;
    unsigned sum, cnt, mine, sp = 0u;
    for (;;) {
        sum = 0u; cnt = 0u; mine = 0u;
#pragma unroll
        for (unsigned j = 0; j < 16; ++j) { const unsigned c = xb_ld(&bar[XB_XCNT(j)]); sum += c; cnt += (c > 0u) ? 1u : 0u; mine = (j == x) ? c : mine; }
        if (sum == G) break;
        __builtin_amdgcn_s_sleep(1);
        if ((++sp & 255u) == 0u) { if (xb_ld(&bar[XB_TMO])) break; if (sp > XB_SPIN_CAP) { atomicAdd(&bar[XB_TMO], 1u); break; } }
    }
    nloc = mine > 0u ? mine : 1u; nx = cnt > 0u ? cnt : 1u;
}
__device__ __forceinline__ void xcd_barrier(const XcdBarrier& b) {
    asm volatile("s_waitcnt vmcnt(0)" ::: "memory");
    __syncthreads();
    if (threadIdx.x == 0) {
        unsigned* bar = b.bar;
        __builtin_amdgcn_s_waitcnt(0);
        unsigned nloc = b.st[0], nx = b.st[1];
        if (nloc == 0u) { xcd_barrier_complete(bar, b.x, nloc, nx); b.st[0] = nloc; b.st[1] = nx; }
        const unsigned old = xb_add(&bar[XB_XSUB(b.x)], 1u);
        const unsigned gen = old / nloc;
        if (old + 1u == (gen + 1u) * nloc) {
            __builtin_amdgcn_fence(__ATOMIC_RELEASE, "agent");
            asm volatile("s_waitcnt vmcnt(0)" ::: "memory");
            const unsigned og = xb_add(&bar[XB_TOP], 1u);
            const unsigned tg = og / nx;
            if (og + 1u == (tg + 1u) * nx) xb_add(&bar[XB_TOPGEN], 1u);
            else XB_SPIN(xb_ld(&bar[XB_TOPGEN]) == tg, bar);
            __builtin_amdgcn_fence(__ATOMIC_ACQUIRE, "agent");
            xb_add(&bar[XB_XGEN(b.x)], 1u);
            asm volatile("s_waitcnt vmcnt(0)" ::: "memory");
        } else {
            XB_SPIN(xb_ld(&bar[XB_XGEN(b.x)]) == gen, bar);
            __builtin_amdgcn_fence(__ATOMIC_ACQUIRE, "agent");
            asm volatile("s_waitcnt vmcnt(0)" ::: "memory");
        }
    }
    __syncthreads();
}

__device__ __forceinline__ float wave_sum(float v) {
#pragma unroll
    for (int o = 1; o < 64; o <<= 1) v += __shfl_xor(v, o);
    return v;
}

__device__ __forceinline__ int map_row(int mode, int n) {
    if (mode == 1) { if (n >= 768 && n < 1536) { const int d = (n - 768) & 63; if (d >= 4 && d < 8) n += 4; else if (d >= 8 && d < 12) n -= 4; } return n; }
    if (mode == 2) return (n >> 7) * 256 + (n & 127);
    if (mode == 3) return (n >> 7) * 256 + 128 + (n & 127);
    return n;
}
__device__ __forceinline__ void transpose_item(const float* W, int K, int N, bf16* WT, int mode, const float* kscale, LAS float* scr, int item, int lane) {
    const int nblk = N / 32, kb = item / nblk, nb = item % nblk, k0 = 64 * kb, n0 = 32 * nb;
#pragma unroll 8
    for (int i = 0; i < 32; ++i) { const int kk = 2 * i + (lane >> 5); float v = W[(size_t)(k0 + kk) * N + n0 + (lane & 31)]; if (kscale) v *= kscale[k0 + kk]; scr[kk * 33 + (lane & 31)] = v; }
    LDS_WAIT(); asm volatile("" ::: "memory");
    const int c = lane & 7;
#pragma unroll
    for (int j = 0; j < 4; ++j) { const int n = (lane >> 3) + 8 * j; const LAS float* s = scr + (8 * c) * 33 + n;
        v4u o; o.x = pk2(s[0 * 33], s[1 * 33]); o.y = pk2(s[2 * 33], s[3 * 33]); o.z = pk2(s[4 * 33], s[5 * 33]); o.w = pk2(s[6 * 33], s[7 * 33]);
        *(GAS v4u*)(WT + (size_t)map_row(mode, n0 + n) * K + k0 + 8 * c) = o; }
    LDS_WAIT(); asm volatile("" ::: "memory");
}
template <int YMODE, bool ROUTER, bool WRITE_BF>
__device__ __forceinline__ void ln_phase(const float* resid, const bf16* Y0, const int* tok_pair, const float* tok_gate, const float* gam, const float* bet, float* out, bf16* xbf,
                                         const float* wr, gu32* cnt, int* tok_e, int* tok_s, float* tok_g, LAS unsigned char* L, int gw, int NGW, int lane) {
    int tidx = threadIdx.x; asm volatile("" : "+v"(lane), "+v"(tidx));
    LAS float* wrT = (LAS float*)L;
    LAS unsigned* cntl = (LAS unsigned*)(L + 32768);
    LAS int* rec = (LAS int*)(L + 32768 + 64) + (tidx >> 6) * (6 * 64);
    if (ROUTER) { for (int i = tidx; i < D * NEXP; i += NWAVES * 64) wrT[(i & 7) * D + (i >> 3)] = wr[i]; if (tidx < 16) cntl[tidx] = 0u; __syncthreads(); }
    int nrow = 0;
    f32x4 gv[4], bv[4];
#pragma unroll
    for (int j = 0; j < 4; ++j) { gv[j] = *(const f32x4*)(gam + 4 * lane + 256 * j); bv[j] = *(const f32x4*)(bet + 4 * lane + 256 * j); }
    for (int m = gw; m < M; m += NGW) {
        const GAS f32x4* xr = (const GAS f32x4*)(resid + (size_t)m * D) + lane;
        f32x4 v[4]; float s = 0.f;
        if (YMODE == 0) {
            const GAS v2u* yr = (const GAS v2u*)(Y0 + (size_t)m * D) + lane;
#pragma unroll
            for (int j = 0; j < 4; ++j) { const f32x4 x = xr[64 * j]; const v2u w = yr[64 * j]; v[j].x = ALPHA * x.x + bflo(w.x); v[j].y = ALPHA * x.y + bfhi(w.x); v[j].z = ALPHA * x.z + bflo(w.y); v[j].w = ALPHA * x.w + bfhi(w.y); }
        } else {
            const int p0 = tok_pair[2 * m], p1 = tok_pair[2 * m + 1]; const float g0 = tok_gate[2 * m], g1 = tok_gate[2 * m + 1];
            const GAS v2u* y0 = (const GAS v2u*)(Y0 + (size_t)p0 * D) + lane; const GAS v2u* y1 = (const GAS v2u*)(Y0 + (size_t)p1 * D) + lane;
#pragma unroll
            for (int j = 0; j < 4; ++j) { const f32x4 x = xr[64 * j]; const v2u a = y0[64 * j], b = y1[64 * j];
                v[j].x = ALPHA * x.x + (g0 * bflo(a.x) + g1 * bflo(b.x)); v[j].y = ALPHA * x.y + (g0 * bfhi(a.x) + g1 * bfhi(b.x));
                v[j].z = ALPHA * x.z + (g0 * bflo(a.y) + g1 * bflo(b.y)); v[j].w = ALPHA * x.w + (g0 * bfhi(a.y) + g1 * bfhi(b.y)); }
        }
#pragma unroll
        for (int j = 0; j < 4; ++j) s += (v[j].x + v[j].y) + (v[j].z + v[j].w);
        const float mean = wave_sum(s) * (1.f / D); float s2 = 0.f;
#pragma unroll
        for (int j = 0; j < 4; ++j) { v[j] = v[j] - mean; s2 += (v[j].x * v[j].x + v[j].y * v[j].y) + (v[j].z * v[j].z + v[j].w * v[j].w); }
        const float rstd = 1.0f / sqrtf(wave_sum(s2) * (1.f / D) + LN_EPS);
        GAS f32x4* orow = (GAS f32x4*)(out + (size_t)m * D) + lane; GAS v2u* brow = (GAS v2u*)(xbf + (size_t)m * D) + lane;
#pragma unroll
        for (int j = 0; j < 4; ++j) { v[j] = v[j] * rstd * gv[j] + bv[j]; orow[64 * j] = v[j]; if (WRITE_BF) { v2u w; w.x = pk2(v[j].x, v[j].y); w.y = pk2(v[j].z, v[j].w); brow[64 * j] = w; } }
        if (ROUTER) {
            float lg[8];
#pragma unroll
            for (int e = 0; e < 8; ++e) { float a = 0.f;
#pragma unroll
                for (int j = 0; j < 4; ++j) { const f32x4 w = *(const LAS f32x4*)(wrT + e * D + 4 * lane + 256 * j); a += (v[j].x * w.x + v[j].y * w.y) + (v[j].z * w.z + v[j].w * w.w); }
                lg[e] = wave_sum(a); }
            int i0 = 0;
#pragma unroll
            for (int e = 1; e < 8; ++e) if (lg[e] > lg[i0]) i0 = e;
            int i1 = (i0 == 0) ? 1 : 0;
#pragma unroll
            for (int e = 0; e < 8; ++e) if (e != i0 && lg[e] > lg[i1]) i1 = e;
            if (lane == 0) {
                const float e1 = expf(lg[i1] - lg[i0]); const float g0 = 1.f / (1.f + e1), g1 = e1 / (1.f + e1);
                const int s0 = (int)__hip_atomic_fetch_add(cntl + i0, 1u, __ATOMIC_RELAXED, __HIP_MEMORY_SCOPE_WORKGROUP); const int s1 = (int)__hip_atomic_fetch_add(cntl + i1, 1u, __ATOMIC_RELAXED, __HIP_MEMORY_SCOPE_WORKGROUP);
                LAS int* rc = rec + 6 * (nrow & 63); rc[0] = i0; rc[1] = i1; rc[2] = s0; rc[3] = s1; rc[4] = __float_as_int(g0); rc[5] = __float_as_int(g1);
            }
            ++nrow;
        }
    }
    if (ROUTER) {
        __syncthreads();
        if (tidx < 8) cntl[8 + tidx] = __hip_atomic_fetch_add(cnt + 64 * tidx, cntl[tidx], RLX_AGENT);
        __syncthreads();
        if (lane < nrow) { const int m = gw + lane * NGW; const LAS int* rc = rec + 6 * lane; const int i0 = rc[0], i1 = rc[1];
            tok_e[2 * m] = i0; tok_e[2 * m + 1] = i1; tok_s[2 * m] = (int)cntl[8 + i0] + rc[2]; tok_s[2 * m + 1] = (int)cntl[8 + i1] + rc[3];
            tok_g[2 * m] = __int_as_float(rc[4]); tok_g[2 * m + 1] = __int_as_float(rc[5]); }
    }
}
__device__ __forceinline__ void moe_gather(const gu32* cnt, const int* tok_e, int* tok_s, const bf16* xbf, bf16* Xs, int* tile_e, LAS unsigned char* L, int gw, int NGW, int lane) {
    int tidx = threadIdx.x; asm volatile("" : "+v"(lane), "+v"(tidx));
    LAS int* lb = (LAS int*)L;
    if (tidx == 0) { int acc = 0; for (int e = 0; e < 8; ++e) { const int c = (int)cnt[64 * e]; lb[e] = acc; lb[8 + e] = c; acc += (c + 255) & ~255; } lb[16] = acc >> 8; }
    __syncthreads();
    if (blockIdx.x == 0) { const int nt = lb[16]; for (int t = tidx; t < nt; t += NWAVES * 64) { int e = 0; for (int k = 1; k < 8; ++k) if (t * 256 >= lb[k]) e = k; tile_e[t] = e; } if (tidx == 0) tile_e[TMAX] = nt; }
    for (int m = gw; m < M; m += NGW) {
        const GAS v4u* src = (const GAS v4u*)(xbf + (size_t)m * D) + lane; const v4u a = src[0], b = src[64];
#pragma unroll
        for (int k = 0; k < 2; ++k) { const int e = tok_e[2 * m + k]; const int pr = lb[e] + tok_s[2 * m + k]; GAS v4u* dst = (GAS v4u*)(Xs + (size_t)pr * D) + lane; dst[0] = a; dst[64] = b; if (lane == 0) tok_s[2 * m + k] = pr; }
    }
    for (int e = 0; e < 8; ++e) { const int c = lb[8 + e], np = ((c + 255) & ~255) - c;
        for (int r = gw; r < np; r += NGW) { GAS v4u* dst = (GAS v4u*)(Xs + (size_t)(lb[e] + c + r) * D) + lane; dst[0] = (v4u){0u, 0u, 0u, 0u}; dst[64] = (v4u){0u, 0u, 0u, 0u}; } }
}
typedef short v4i16_t __attribute__((ext_vector_type(4)));
typedef float f32x2_t __attribute__((ext_vector_type(2))); typedef __bf16 bf16x2_t __attribute__((ext_vector_type(2)));
__device__ __forceinline__ int crow(int r, int hi) { return (r & 3) + 8 * (r >> 2) + 4 * hi; }
__device__ __forceinline__ unsigned cvtpk(float lo, float hi) { f32x2_t v = {lo, hi}; bf16x2_t b = __builtin_convertvector(v, bf16x2_t); return __builtin_bit_cast(unsigned, b); }
__device__ __forceinline__ float ex2(float x) { return __builtin_amdgcn_exp2f(x); }
__device__ __forceinline__ float xhalf(float x) { return __shfl_xor(x, 32); }
__device__ __forceinline__ bf16x8 vfrag(LAS unsigned char* p) {
    const v4i16_t lo = __builtin_amdgcn_ds_read_tr16_b64_v4i16((LAS v4i16_t*)p);
    const v4i16_t hi = __builtin_amdgcn_ds_read_tr16_b64_v4i16((LAS v4i16_t*)(p + 512));
    return (bf16x8){lo[0], lo[1], lo[2], lo[3], hi[0], hi[1], hi[2], hi[3]};
}
__device__ __forceinline__ bf16x8 pfrag(const unsigned* pw) { v4u t = {pw[0], pw[1], pw[2], pw[3]}; return __builtin_bit_cast(bf16x8, t); }
#define MFMA32(a, b, c) __builtin_amdgcn_mfma_f32_32x32x16_bf16((a), (b), (c), 0, 0, 0)

template <int NS>
__device__ __forceinline__ void softmax_update(f32x16 (&s)[NS], float& m, float& l, f32x16 (&O)[2], unsigned (&pw)[NS][8]) {
    float mx = s[0][0];
#pragma unroll
    for (int i = 0; i < NS; ++i)
#pragma unroll
        for (int r = 0; r < 16; ++r) mx = fmaxf(mx, s[i][r]);
    mx = fmaxf(mx, xhalf(mx));
    const float mn = fmaxf(m, mx);
    if (__any(mn > m)) { const float alpha = ex2(m - mn); l *= alpha;
#pragma unroll
        for (int d = 0; d < 2; ++d)
#pragma unroll
            for (int r = 0; r < 16; ++r) O[d][r] *= alpha; }
    m = mn;
    float rs = 0.f;
#pragma unroll
    for (int i = 0; i < NS; ++i) {
#pragma unroll
        for (int r = 0; r < 16; ++r) { s[i][r] = ex2(s[i][r] - mn); rs += s[i][r]; }
#pragma unroll
        for (int k = 0; k < 8; ++k) pw[i][k] = cvtpk(s[i][2 * k], s[i][2 * k + 1]);
    }
    l += rs;
}

constexpr int A_KBUF = 0, A_VBUF = 16384;
__device__ __forceinline__ void attn_a_unit(const bf16* QKV, bf16* Oout, int b, int h, int qblk, float lam, float lam_init, const float* ng, LAS unsigned char* L, int wave, int lane) {
    const int r32 = lane & 31, hi = lane >> 5;
    const size_t rowb = (size_t)b * SEQ;
    const bf16* qp = QKV + (rowb + qblk * 256 + wave * 32 + r32) * NQKV + h * 64 + 8 * hi;
    bf16x8 qf[2][2];
#pragma unroll
    for (int mp = 0; mp < 2; ++mp)
#pragma unroll
        for (int d0 = 0; d0 < 2; ++d0) qf[mp][d0] = *(const bf16x8*)(qp + 32 * mp + 16 * d0);
    const bf16* ksrc = QKV + (rowb + lane) * NQKV + 256 + h * 64 + wave * 8;
    const bf16* vsrc = QKV + (rowb + 16 * (wave & 3) + (lane >> 2)) * NQKV + 512 + h * 64 + 32 * (wave >> 2) + 8 * (lane & 3);
    LAS unsigned char* kdst = L + A_KBUF + wave * 1024 + lane * 16;
    LAS unsigned char* vdst = L + A_VBUF + wave * 1024 + lane * 16;
    LAS unsigned char* kfr = L + A_KBUF + hi * 1024 + r32 * 16;
    LAS unsigned char* vfr = L + A_VBUF + ((lane >> 4) & 1) * 32 + (lane & 3) * 8 + (4 * hi + ((lane & 15) >> 2)) * 64;
    f32x16 O[2][2]; float mrow[2], lrow[2];
#pragma unroll
    for (int mp = 0; mp < 2; ++mp) { mrow[mp] = -1e30f; lrow[mp] = 0.f;
#pragma unroll
        for (int d = 0; d < 2; ++d)
#pragma unroll
            for (int r = 0; r < 16; ++r) O[mp][d][r] = 0.f; }
    v4u kreg = *(const v4u*)ksrc, vreg = *(const v4u*)vsrc;
    *(LAS v4u*)kdst = kreg; *(LAS v4u*)vdst = vreg;
    __syncthreads();
    constexpr int NT = SEQ / 64;
    for (int t = 0; t < NT; ++t) {
        const int cur = (t & 1) * 8192, nxt = 8192 - cur;
        if (t + 1 < NT) { kreg = *(const v4u*)(ksrc + (size_t)(t + 1) * 64 * NQKV); vreg = *(const v4u*)(vsrc + (size_t)(t + 1) * 64 * NQKV); }
        unsigned pw[2][2][8];
#pragma unroll
        for (int mp = 0; mp < 2; ++mp) {
            f32x16 s[2];
#pragma unroll
            for (int r = 0; r < 16; ++r) { s[0][r] = 0.f; s[1][r] = 0.f; }
#pragma unroll
            for (int d0 = 0; d0 < 2; ++d0) {
                const bf16x8 k0 = *(LAS bf16x8*)(kfr + cur + (4 * mp + 2 * d0) * 1024), k1 = *(LAS bf16x8*)(kfr + cur + (4 * mp + 2 * d0) * 1024 + 512);
                s[0] = MFMA32(k0, qf[mp][d0], s[0]); s[1] = MFMA32(k1, qf[mp][d0], s[1]);
            }
            softmax_update<2>(s, mrow[mp], lrow[mp], O[mp], pw[mp]);
        }
#pragma unroll
        for (int ks = 0; ks < 4; ++ks)
#pragma unroll
            for (int d0 = 0; d0 < 2; ++d0) {
                const bf16x8 vf = vfrag(vfr + cur + d0 * 4096 + ks * 1024);
                O[0][d0] = MFMA32(vf, pfrag(&pw[0][ks >> 1][4 * (ks & 1)]), O[0][d0]);
                O[1][d0] = MFMA32(vf, pfrag(&pw[1][ks >> 1][4 * (ks & 1)]), O[1][d0]);
            }
        if (t + 1 < NT) { *(LAS v4u*)(kdst + nxt) = kreg; *(LAS v4u*)(vdst + nxt) = vreg; }
        __syncthreads();
    }
    const float i0 = 1.0f / (lrow[0] + xhalf(lrow[0])), i1 = lam / (lrow[1] + xhalf(lrow[1]));
    float ss = 0.f;
#pragma unroll
    for (int d = 0; d < 2; ++d)
#pragma unroll
        for (int r = 0; r < 16; ++r) { const float o = O[0][d][r] * i0 - O[1][d][r] * i1; O[0][d][r] = o; ss += o * o; }
    ss += xhalf(ss);
    const float rr = rsqrtf(ss * (1.0f / 64.0f) + LN_EPS) * (1.0f - lam_init);
    bf16* op = Oout + (rowb + qblk * 256 + wave * 32 + r32) * D + h * 64 + 4 * hi;
#pragma unroll
    for (int d = 0; d < 2; ++d)
#pragma unroll
        for (int g = 0; g < 4; ++g) { const f32x4 gg = *(const f32x4*)(ng + 32 * d + 8 * g + 4 * hi);
            v2u w; w.x = cvtpk(O[0][d][4 * g] * rr * gg.x, O[0][d][4 * g + 1] * rr * gg.y); w.y = cvtpk(O[0][d][4 * g + 2] * rr * gg.z, O[0][d][4 * g + 3] * rr * gg.w);
            *(v2u*)(op + 32 * d + 8 * g) = w; }
}

struct AttState { f32x16 O[2]; float m, l; };
template <class MaskFn>
__device__ __forceinline__ void block_step(AttState& st, const bf16x8 (&qf)[4], const bf16* kp, const bf16* vp0, const bf16* vp1, LAS unsigned char* vst, int lane, const MaskFn& mask) {
    const int hi = lane >> 5;
    bf16x8 kf[4];
#pragma unroll
    for (int d0 = 0; d0 < 4; ++d0) kf[d0] = *(const bf16x8*)(kp + 16 * d0);
    const v4u v00 = *(const v4u*)vp0, v01 = *(const v4u*)(vp0 + 32), v10 = *(const v4u*)vp1, v11 = *(const v4u*)(vp1 + 32);
    f32x16 s[1];
#pragma unroll
    for (int r = 0; r < 16; ++r) s[0][r] = 0.f;
#pragma unroll
    for (int d0 = 0; d0 < 4; ++d0) s[0] = MFMA32(kf[d0], qf[d0], s[0]);
#pragma unroll
    for (int r = 0; r < 16; ++r) s[0][r] = mask(r, s[0][r]);
    unsigned pw[1][8];
    softmax_update<1>(s, st.m, st.l, st.O, pw);
    *(LAS v4u*)(vst + 0 * 1024 + lane * 16) = v00; *(LAS v4u*)(vst + 1 * 1024 + lane * 16) = v10;
    *(LAS v4u*)(vst + 2 * 1024 + lane * 16) = v01; *(LAS v4u*)(vst + 3 * 1024 + lane * 16) = v11;
    LAS unsigned char* vfr = vst + ((lane >> 4) & 1) * 32 + (lane & 3) * 8 + (4 * hi + ((lane & 15) >> 2)) * 64;
#pragma unroll
    for (int ks = 0; ks < 2; ++ks)
#pragma unroll
        for (int d0 = 0; d0 < 2; ++d0) st.O[d0] = MFMA32(vfrag(vfr + (d0 * 2 + ks) * 1024), pfrag(&pw[0][4 * ks]), st.O[d0]);
}

constexpr int B_ST_O = 0, B_ST_ROW = 272, B_ST_M = 256 * 272, B_ST_L = B_ST_M + 1024, B_VST = 73728;
struct MaskB { int base; bool colok;
    __device__ __forceinline__ float operator()(int r, float s) const { const int dl = base + (r & 3) + 8 * (r >> 2); return (colok && (unsigned)(dl + 64) <= 128u) ? s : -INFINITY; } };
__device__ __forceinline__ void st_store(const AttState& st, LAS unsigned char* L, int ql, int hi, bool fin) {
    LAS float* row = (LAS float*)(L + B_ST_O + ql * B_ST_ROW);
#pragma unroll
    for (int d = 0; d < 2; ++d)
#pragma unroll
        for (int g = 0; g < 4; ++g) *(LAS f32x4*)(row + 32 * d + 8 * g + 4 * hi) = (f32x4){st.O[d][4 * g], st.O[d][4 * g + 1], st.O[d][4 * g + 2], st.O[d][4 * g + 3]};
    const float lt = st.l + xhalf(st.l);
    if (hi == 0) { ((LAS float*)(L + B_ST_M))[ql] = st.m; ((LAS float*)(L + B_ST_L))[ql] = lt; }
}
__device__ __forceinline__ void st_load(AttState& st, LAS unsigned char* L, int ql, int hi) {
    LAS float* row = (LAS float*)(L + B_ST_O + ql * B_ST_ROW);
#pragma unroll
    for (int d = 0; d < 2; ++d)
#pragma unroll
        for (int g = 0; g < 4; ++g) { const f32x4 v = *(LAS f32x4*)(row + 32 * d + 8 * g + 4 * hi); st.O[d][4 * g] = v.x; st.O[d][4 * g + 1] = v.y; st.O[d][4 * g + 2] = v.z; st.O[d][4 * g + 3] = v.w; }
    st.m = ((LAS float*)(L + B_ST_M))[ql]; st.l = hi == 0 ? ((LAS float*)(L + B_ST_L))[ql] : 0.f;
}
__device__ __forceinline__ void attn_b_unit(const bf16* QKV, bf16* Oout, int b, int h, int sp, LAS unsigned char* L, int wave, int lane) {
    const int r32 = lane & 31, hi = lane >> 5, c = r32;
    const size_t rowb = (size_t)b * SEQ; const int p0 = 256 * sp;
    const bf16* Qh = QKV + rowb * NQKV + 768 + h * 64; const bf16* Kh = QKV + rowb * NQKV + 1152 + h * 64; const bf16* Vh = QKV + rowb * NQKV + 1536 + h * 64;
    LAS unsigned char* vst = L + B_VST + wave * 4096;
    AttState st; bf16x8 qf[4];
    {   const int qpos = p0 + 32 * wave + c;
#pragma unroll
        for (int d0 = 0; d0 < 4; ++d0) qf[d0] = *(const bf16x8*)(Qh + (size_t)qpos * NQKV + 16 * d0 + 8 * hi);
        st.m = -1e30f; st.l = 0.f;
#pragma unroll
        for (int d = 0; d < 2; ++d)
#pragma unroll
            for (int r = 0; r < 16; ++r) st.O[d][r] = 0.f;
        for (int j = 0; j < 5; ++j) { const int k0 = p0 + 32 * wave - 64 + 32 * j; if (k0 < 0 || k0 >= SEQ) continue;
            MaskB mk{32 * j - 64 - c + 4 * hi, true};
            block_step(st, qf, Kh + (size_t)(k0 + r32) * NQKV + 8 * hi, Vh + (size_t)(k0 + (lane >> 2)) * NQKV + 8 * (lane & 3), Vh + (size_t)(k0 + 16 + (lane >> 2)) * NQKV + 8 * (lane & 3), vst, lane, mk); }
        st_store(st, L, 32 * wave + c, hi, false);
    }
    __syncthreads();
    {   const int rho = wave & 3, u = wave >> 2; const int ql = rho + 128 * u + 4 * c;
#pragma unroll
        for (int d0 = 0; d0 < 4; ++d0) qf[d0] = *(const bf16x8*)(Qh + (size_t)(p0 + ql) * NQKV + 16 * d0 + 8 * hi);
        st_load(st, L, ql, hi);
        const int mq0 = p0 / 4 + 32 * u;
        for (int j = 0; j < 5; ++j) { const int m0 = mq0 - 64 + 32 * j; if (m0 < 0 || m0 >= SEQ / 4) continue;
            MaskB mk{32 * j - 64 - c + 4 * hi, true};
            block_step(st, qf, Kh + (size_t)(rho + 4 * (m0 + r32)) * NQKV + 8 * hi, Vh + (size_t)(rho + 4 * (m0 + (lane >> 2))) * NQKV + 8 * (lane & 3), Vh + (size_t)(rho + 4 * (m0 + 16 + (lane >> 2))) * NQKV + 8 * (lane & 3), vst, lane, mk); }
        __syncthreads();
        st_store(st, L, ql, hi, false);
    }
    __syncthreads();
    {   const int rq = 2 * wave + (c >> 4), i = c & 15; const int ql = rq + 16 * i;
#pragma unroll
        for (int d0 = 0; d0 < 4; ++d0) qf[d0] = *(const bf16x8*)(Qh + (size_t)(p0 + ql) * NQKV + 16 * d0 + 8 * hi);
        st_load(st, L, ql, hi);
        const int mq0 = p0 / 16;
        for (int rb = 0; rb < 2; ++rb) { const int rho = 2 * wave + rb;
            for (int jb = 0; jb < 4; ++jb) { const int m0 = 32 * jb; if (m0 + 31 < mq0 - 64 || m0 > mq0 + 15 + 64) continue;
                MaskB mk{m0 - (mq0 + i) + 4 * hi, (c >> 4) == rb};
                block_step(st, qf, Kh + (size_t)(rho + 16 * (m0 + r32)) * NQKV + 8 * hi, Vh + (size_t)(rho + 16 * (m0 + (lane >> 2))) * NQKV + 8 * (lane & 3), Vh + (size_t)(rho + 16 * (m0 + 16 + (lane >> 2))) * NQKV + 8 * (lane & 3), vst, lane, mk); } }
        const float inv = 1.0f / (st.l + xhalf(st.l));
        bf16* op = Oout + (rowb + p0 + ql) * D + 256 + h * 64 + 4 * hi;
#pragma unroll
        for (int d = 0; d < 2; ++d)
#pragma unroll
            for (int g = 0; g < 4; ++g) { v2u w; w.x = cvtpk(st.O[d][4 * g] * inv, st.O[d][4 * g + 1] * inv); w.y = cvtpk(st.O[d][4 * g + 2] * inv, st.O[d][4 * g + 3] * inv); *(v2u*)(op + 32 * d + 8 * g) = w; }
    }
    __syncthreads();
}

constexpr int C_RPB = 110592;
struct MaskC1 { int cb, bb; const LAS float* rp;
    __device__ __forceinline__ float operator()(int r, float s) const { const int t = (r & 3) + 8 * (r >> 2); return ((unsigned)(cb + t) < 16u) ? s + rp[bb + t] : -INFINITY; } };
struct MaskC2 { int cb, bb; const LAS float* rp;
    __device__ __forceinline__ float operator()(int r, float s) const { const int t = (r & 3); return ((unsigned)(cb + t) < 16u) ? s + rp[bb + 31 * (r >> 2) + t] : -INFINITY; } };
__device__ __forceinline__ void attn_c_tile(const bf16* QKV, bf16* Oout, int b, int h, int grow, int half, LAS unsigned char* L, int wave, int lane) {
    const int r32 = lane & 31, hi = lane >> 5;
    const size_t rowb = (size_t)b * SEQ;
    const int c = 32 * half + r32, w0 = half ? 24 : 0;
    int rs = grow - 4; rs = rs < 0 ? 0 : (rs > 24 ? 24 : rs);
    int cs = c - 8; cs = cs < 0 ? 0 : (cs > 48 ? 48 : cs);
    const bf16* Qh = QKV + rowb * NQKV + 1920 + h * 64; const bf16* Kh = QKV + rowb * NQKV + 2304 + h * 64; const bf16* Vh = QKV + rowb * NQKV + 2688 + h * 64;
    LAS unsigned char* vst = L + B_VST + wave * 4096;
    const LAS float* rp = (const LAS float*)(L + C_RPB) + h * 15 * 31;
    AttState st; bf16x8 qf[4];
#pragma unroll
    for (int d0 = 0; d0 < 4; ++d0) qf[d0] = *(const bf16x8*)(Qh + (size_t)(grow * 64 + c) * NQKV + 16 * d0 + 8 * hi);
    st.m = -1e30f; st.l = 0.f;
#pragma unroll
    for (int d = 0; d < 2; ++d)
#pragma unroll
        for (int r = 0; r < 16; ++r) st.O[d][r] = 0.f;
    for (int j = 0; j < 8; ++j) { const int kr = rs + j; const int tok0 = kr * 64 + w0;
        MaskC1 mk{w0 + 4 * hi - cs, (kr - grow + 7) * 31 + (w0 + 4 * hi - c + 15), rp};
        block_step(st, qf, Kh + (size_t)(tok0 + r32) * NQKV + 8 * hi, Vh + (size_t)(tok0 + (lane >> 2)) * NQKV + 8 * (lane & 3), Vh + (size_t)(tok0 + 16 + (lane >> 2)) * NQKV + 8 * (lane & 3), vst, lane, mk); }
    for (int j = 0; j < 2; ++j) { const int kr0 = rs + 4 * j;
        MaskC2 mk{w0 + 32 + 4 * hi - cs, (kr0 - grow + 7) * 31 + (w0 + 32 + 4 * hi - c + 15), rp};
        const int kk = r32, k0 = lane >> 2, k1 = 16 + (lane >> 2);
        block_step(st, qf, Kh + (size_t)((kr0 + (kk >> 3)) * 64 + w0 + 32 + (kk & 7)) * NQKV + 8 * hi, Vh + (size_t)((kr0 + (k0 >> 3)) * 64 + w0 + 32 + (k0 & 7)) * NQKV + 8 * (lane & 3),
                   Vh + (size_t)((kr0 + (k1 >> 3)) * 64 + w0 + 32 + (k1 & 7)) * NQKV + 8 * (lane & 3), vst, lane, mk); }
    const float inv = 1.0f / (st.l + xhalf(st.l));
    bf16* op = Oout + (rowb + grow * 64 + c) * D + 640 + h * 64 + 4 * hi;
#pragma unroll
    for (int d = 0; d < 2; ++d)
#pragma unroll
        for (int g = 0; g < 4; ++g) { v2u w; w.x = cvtpk(st.O[d][4 * g] * inv, st.O[d][4 * g + 1] * inv); w.y = cvtpk(st.O[d][4 * g + 2] * inv, st.O[d][4 * g + 3] * inv); *(v2u*)(op + 32 * d + 8 * g) = w; }
}

__device__ __forceinline__ void attn_phase(const bf16* QKV, bf16* Oout, const float* lamp, const float* ng, const float* rpb, float lam_init, LAS unsigned char* L, int vcu, int G, int wave, int lane_in) {
    int lane = lane_in, tidx = threadIdx.x; asm volatile("" : "+v"(lane), "+v"(tidx));
    float s01 = 0.f, s23 = 0.f;
    for (int d = 0; d < 32; ++d) { s01 += lamp[d] * lamp[32 + d]; s23 += lamp[64 + d] * lamp[96 + d]; }
    const float lam = expf(s01) - expf(s23) + lam_init;
    for (int i = tidx; i < 6 * 15 * 31; i += NWAVES * 64) ((LAS float*)(L + C_RPB))[i] = rpb[i] * LOG2E;
    __syncthreads();
    for (int rep = 0; rep < REP_ATTA; ++rep) for (int u = vcu; u < BATCH * 4 * 8; u += G) attn_a_unit(QKV, Oout, u >> 5, (u >> 3) & 3, u & 7, lam, lam_init, ng, L, wave, lane);
    __syncthreads();
    for (int rep = 0; rep < REP_ATTBC; ++rep) for (int uu = vcu; uu < 768; uu += G) {
        if (uu < 384) { attn_b_unit(QKV, Oout, uu / 48, (uu / 8) % 6, uu & 7, L, wave, lane); }
        else { const int id = uu - 384; attn_c_tile(QKV, Oout, id / 48, (id / 8) % 6, 4 * (id & 7) + (wave >> 1), wave & 1, L, wave, lane); }
    }
    __syncthreads();
}
struct Args { const float* in[18]; float* out; unsigned char* ws; int ph_lo, ph_hi; };
enum { I_X = 0, I_WIN, I_WOUT, I_BETA, I_LAMBDA, I_NORMG, I_RPB, I_LN1G, I_LN1B, I_LN2G, I_LN2B, I_FG, I_FU, I_FD, I_MR, I_MG, I_MU, I_MD };
constexpr int PH_PER_LAYER = 12, PH_END = 1 + 2 * PH_PER_LAYER;

__device__ __forceinline__ void prologue(const Args& args, LAS unsigned char* L, int gw, int NGW, int wave, int lane) {
    unsigned char* ws = args.ws;
    LAS float* scr = (LAS float*)(L + wave * 16384);
    int start = 0;
    for (int j = 0; j < 31; ++j) {
        const float* W; int K, N, mode; bf16* WT; const float* ks = nullptr;
        if (j < 4) { const int l = j >> 1;
            if ((j & 1) == 0) { W = args.in[I_WIN] + (size_t)l * D * NQKV; K = D; N = NQKV; mode = 1; WT = (bf16*)(ws + WS_R + R_WIN) + (size_t)l * NQKV * D; }
            else { W = args.in[I_WOUT] + (size_t)l * D * D; K = D; N = D; mode = 0; WT = (bf16*)(ws + WS_R + R_WOUT) + (size_t)l * D * D; ks = args.in[I_BETA] + l * D; } }
        else if (j < 7) {
            if (j == 4) { W = args.in[I_FG]; K = D; N = DFF; mode = 2; WT = (bf16*)(ws + WS_R + R_WGU); }
            else if (j == 5) { W = args.in[I_FU]; K = D; N = DFF; mode = 3; WT = (bf16*)(ws + WS_R + R_WGU); }
            else { W = args.in[I_FD]; K = DFF; N = D; mode = 0; WT = (bf16*)(ws + WS_R + R_WDN); } }
        else { const int e = (j - 7) / 3, kind = (j - 7) % 3;
            if (kind == 0) { W = args.in[I_MG] + (size_t)e * D * DFE; K = D; N = DFE; mode = 2; WT = (bf16*)(ws + WS_WMGU) + (size_t)e * 2 * DFE * D; }
            else if (kind == 1) { W = args.in[I_MU] + (size_t)e * D * DFE; K = D; N = DFE; mode = 3; WT = (bf16*)(ws + WS_WMGU) + (size_t)e * 2 * DFE * D; }
            else { W = args.in[I_MD] + (size_t)e * DFE * D; K = DFE; N = D; mode = 0; WT = (bf16*)(ws + WS_WMDN) + (size_t)e * D * DFE; } }
        const int nit = (K / 64) * (N / 32);
        const int first = (gw - (start % NGW) + NGW) % NGW;
        for (int it = first; it < nit; it += NGW) transpose_item(W, K, N, WT, mode, ks, scr, it, lane);
        start += nit;
    }
    { const float* x = args.in[I_X]; bf16* xbf = (bf16*)(ws + WS_XBF);
      for (int m = gw; m < M; m += NGW) { const GAS f32x4* xr = (const GAS f32x4*)(x + (size_t)m * D) + lane; GAS v2u* o = (GAS v2u*)(xbf + (size_t)m * D) + lane;
#pragma unroll
          for (int j = 0; j < 4; ++j) { const f32x4 v = xr[64 * j]; v2u w; w.x = pk2(v.x, v.y); w.y = pk2(v.z, v.w); o[64 * j] = w; } } }
    { float* ta = (float*)(ws + WS_TAB + T_ROPEA); float* tb = (float*)(ws + WS_TAB + T_ROPEB);
      for (int i = gw * 64 + lane; i < SEQ * 8; i += NGW * 64) {
          const int p = i >> 3, j = i & 7; const float invb = powf(ROPE_THETA, -(float)(2 * j) / 16.0f); const float angb = (float)p * invb;
          tb[p * 16 + j] = (float)cos((double)angb); tb[p * 16 + 8 + j] = (float)sin((double)angb);
          if (j < 4) { const float inva = powf(ROPE_THETA, -(float)(2 * j) / 8.0f); const float anga = (float)p * inva; ta[p * 8 + j] = (float)cos((double)anga); ta[p * 8 + 4 + j] = (float)sin((double)anga); } } }
}

__global__ void __launch_bounds__(NWAVES * 64, 2) mega(Args args) {
    extern __shared__ __attribute__((aligned(16))) unsigned char lds[];
    LAS unsigned char* L = (LAS unsigned char*)lds;
    volatile LAS unsigned* MISC = (volatile LAS unsigned*)(L + MISC_OFF);
    const int tid = threadIdx.x, lane = tid & 63, wave = __builtin_amdgcn_readfirstlane(tid >> 6);
    const int G = gridDim.x; const int bx = blockIdx.x;
    const int vcu = (G % 8 == 0) ? (bx % 8) * (G / 8) + bx / 8 : bx;
    const int gw = vcu * NWAVES + wave, NGW = G * NWAVES;
    unsigned char* ws = args.ws;
    gu32* ctl = (gu32*)(ws + WS_CTL);
    for (int u = tid; u < (LDS_BYTES - RING_BYTES) / 4; u += NWAVES * 64) ((LAS unsigned*)(L + RING_BYTES))[u] = 0u;
    __syncthreads();
    const int lo = args.ph_lo, hi = args.ph_hi;
    XcdBarrier bar; bar.bar = (unsigned*)(ctl + CW_BAR); bar.x = 0; bar.st = nullptr;
    if (hi - lo > 1) bar = xcd_barrier_post((unsigned*)(ctl + CW_BAR), MISC + 8);
#define IN(k) (lo <= (k) && (k) < hi)
#define SEAM(nextk) do { if ((nextk) < hi) xcd_barrier(bar); } while (0)
    bf16* XBF = (bf16*)(ws + WS_XBF);
    unsigned char* R = ws + WS_R;
    const float* ropeA = (const float*)(ws + WS_TAB + T_ROPEA); const float* ropeB = (const float*)(ws + WS_TAB + T_ROPEB);

    if (IN(0)) { _Pragma("unroll") for (int rep = 0; rep < REP_PRO; ++rep) prologue(args, L, gw, NGW, wave, lane); SEAM(1); }

    for (int l = 0; l < DEPTH; ++l) {
        const int pb = 1 + PH_PER_LAYER * l;
        if (hi <= pb || lo >= pb + PH_PER_LAYER) continue;
        if (IN(pb + 0)) {
            pg8::Gemm g{XBF, (const bf16*)(R + R_WIN) + (size_t)l * NQKV * D, M, NQKV, D}; pg8::StaticOrder S; S.init(M, NQKV, G, bx);
            pg8::EpiQKV E{(bf16*)(R + R_QKV), ropeA, ropeB};
            _Pragma("unroll") for (int rep = 0; rep < REP_DENSE; ++rep) pg8::gemm_phase<pg8::EpiQKV, pg8::StaticOrder, true, true>(L, g, S, E);
            SEAM(pb + 1);
        }
        if (IN(pb + 1)) {
            attn_phase((const bf16*)(R + R_QKV), (bf16*)(R + R_O), args.in[I_LAMBDA] + l * 128, args.in[I_NORMG] + l * 64, args.in[I_RPB] + (size_t)l * 6 * 15 * 31,
                       0.8f - 0.6f * expf(-0.3f * (float)l), L, vcu, G, wave, lane);
            SEAM(pb + 2);
        }

        if (IN(pb + 2)) {
            pg8::Gemm g{(const bf16*)(R + R_O), (const bf16*)(R + R_WOUT) + (size_t)l * D * D, M, D, D}; pg8::StaticOrder S; S.init(M, D, G, bx);
            pg8::EpiStoreBf16 E{(bf16*)(R + R_MIX), D, 0, 1 << 20};
            _Pragma("unroll") for (int rep = 0; rep < REP_DENSE; ++rep) pg8::gemm_phase<pg8::EpiStoreBf16, pg8::StaticOrder, true, true>(L, g, S, E);
            SEAM(pb + 3);
        }
        if (IN(pb + 3)) {
            const float* resid = (l == 0) ? args.in[I_X] : (const float*)args.out;
            if ((l & 1) == 0) ln_phase<0, false, true>(resid, (const bf16*)(R + R_MIX), nullptr, nullptr, args.in[I_LN1G] + l * D, args.in[I_LN1B] + l * D, args.out, XBF, nullptr, nullptr, nullptr, nullptr, nullptr, L, gw, NGW, lane);
            else ln_phase<0, true, true>(resid, (const bf16*)(R + R_MIX), nullptr, nullptr, args.in[I_LN1G] + l * D, args.in[I_LN1B] + l * D, args.out, XBF, args.in[I_MR] + (size_t)(l / 2) * D * NEXP, ctl + CW_CNT,
                                         (int*)(ws + WS_TAB + T_TOKE), (int*)(ws + WS_TAB + T_TOKS), (float*)(ws + WS_TAB + T_TOKG), L, gw, NGW, lane);
            SEAM(pb + 4);
        }

        if ((l & 1) == 0) {
            if (IN(pb + 4)) {
                pg8::Gemm g{XBF, (const bf16*)(R + R_WGU), M, 2 * DFF, D}; pg8::StaticOrder S; S.init(M, 2 * DFF, G, bx);
                pg8::EpiSwiglu E{(bf16*)(R + R_H), DFF, 0, 1 << 20};
                _Pragma("unroll") for (int rep = 0; rep < REP_DENSE; ++rep) pg8::gemm_phase<pg8::EpiSwiglu, pg8::StaticOrder, true, true>(L, g, S, E);
                SEAM(pb + 5);
            }
            if (IN(pb + 5)) {
                pg8::Gemm g{(const bf16*)(R + R_H), (const bf16*)(R + R_WDN), M, D, DFF}; pg8::StaticOrder S; S.init(M, D, G, bx);
                pg8::EpiStoreBf16 E{(bf16*)(R + R_F), D, 0, 1 << 20};
                _Pragma("unroll") for (int rep = 0; rep < REP_DENSE; ++rep) pg8::gemm_phase<pg8::EpiStoreBf16, pg8::StaticOrder, true, true>(L, g, S, E);
                SEAM(pb + 9);
            }
        } else {
            const bf16* WMGU = (const bf16*)(ws + WS_WMGU) + (size_t)(l / 2) * NEXP * 2 * DFE * D; const bf16* WMDN = (const bf16*)(ws + WS_WMDN) + (size_t)(l / 2) * NEXP * D * DFE;
            int* tile_e = (int*)(ws + WS_TAB + T_TILEE);
            if (IN(pb + 4)) {
                moe_gather(ctl + CW_CNT, (const int*)(ws + WS_TAB + T_TOKE), (int*)(ws + WS_TAB + T_TOKS), XBF, (bf16*)(R + R_XS), tile_e, L, gw, NGW, lane);
                SEAM(pb + 5);
            }
            for (int p = 0; p < 2; ++p) {
                if (!(IN(pb + 5 + 2 * p) || IN(pb + 6 + 2 * p))) continue;
                const int nt_all = __builtin_amdgcn_readfirstlane(tile_e[TMAX]);
                const int tile0 = p * PASS0_TILES; int nt = nt_all - tile0; nt = nt < 0 ? 0 : (nt > (p == 0 ? PASS0_TILES : HMOE_TILES) ? (p == 0 ? PASS0_TILES : HMOE_TILES) : nt);
                if (IN(pb + 5 + 2 * p)) {
                    pg8::Gemm g{(const bf16*)(R + R_XS), WMGU, 0, 0, D}; pg8::GroupedOrder S{nt, tile0, 2 * DFE / 256, G, bx, 0, tile_e};
                    pg8::EpiSwiglu E{(bf16*)(R + R_HM), DFE, -tile0, 2 * DFE / 256};
                    _Pragma("unroll") for (int rep = 0; rep < REP_MOEGU; ++rep) pg8::gemm_phase<pg8::EpiSwiglu, pg8::GroupedOrder, true, true>(L, g, S, E);
                    SEAM(pb + 6 + 2 * p);
                }
                if (IN(pb + 6 + 2 * p)) {
                    pg8::Gemm g{(const bf16*)(R + R_HM), WMDN, 0, 0, DFE}; pg8::GroupedOrder S{nt, tile0, D / 256, G, bx, 1, tile_e};
                    pg8::EpiStoreBf16 E{(bf16*)(R + R_XS), D, tile0, D / 256};
                    _Pragma("unroll") for (int rep = 0; rep < REP_MOEDN; ++rep) pg8::gemm_phase<pg8::EpiStoreBf16, pg8::GroupedOrder, true, true>(L, g, S, E);
                    SEAM(pb + 7 + 2 * p);
                }
            }

        }
        if (IN(pb + 9)) {
            if ((l & 1) == 0) ln_phase<0, false, true>(args.out, (const bf16*)(R + R_F), nullptr, nullptr, args.in[I_LN2G] + l * D, args.in[I_LN2B] + l * D, args.out, XBF, nullptr, nullptr, nullptr, nullptr, nullptr, L, gw, NGW, lane);
            else ln_phase<1, false, false>(args.out, (const bf16*)(R + R_XS), (const int*)(ws + WS_TAB + T_TOKS), (const float*)(ws + WS_TAB + T_TOKG), args.in[I_LN2G] + l * D, args.in[I_LN2B] + l * D, args.out, XBF,
                                           nullptr, nullptr, nullptr, nullptr, nullptr, L, gw, NGW, lane);
            SEAM(pb + PH_PER_LAYER);
        }

    }
#undef IN
#undef SEAM
}
}
extern "C" void kernel_launch(void* const* d_in, const int* in_sizes, int n_in, void* d_out, int out_size, void* d_ws, size_t ws_size, hipStream_t stream) {
    using namespace mk;
    static int grid = 0;
    if (grid == 0) {
        int dev = 0, cus = 0, per_cu = 0;
        if (n_in != 18 || out_size != M * D || ws_size < WS_END) { fprintf(stderr, "kernel_launch: unexpected problem (n_in %d, out %d, ws %zu < %zu)\n", n_in, out_size, ws_size, (size_t)WS_END); grid = -1; return; }
        if (hipGetDevice(&dev) != hipSuccess || hipDeviceGetAttribute(&cus, hipDeviceAttributeMultiprocessorCount, dev) != hipSuccess) { grid = -1; return; }
        if (hipFuncSetAttribute((const void*)mega, hipFuncAttributeMaxDynamicSharedMemorySize, LDS_BYTES) != hipSuccess) { fprintf(stderr, "kernel_launch: hipFuncSetAttribute failed\n"); grid = -1; return; }
        if (hipOccupancyMaxActiveBlocksPerMultiprocessor(&per_cu, (const void*)mega, NWAVES * 64, LDS_BYTES) != hipSuccess || per_cu < 1) { fprintf(stderr, "kernel_launch: occupancy query reports %d workgroups per CU\n", per_cu); }
        (void)hipGetLastError();
        grid = cus;
    }
    if (grid < 0) return;
    unsigned char* ws = (unsigned char*)d_ws;
    (void)hipMemsetAsync(ws + WS_CTL, 0, CTL_ZERO_BYTES, stream);
    Args a{};
    for (int i = 0; i < 18; ++i) a.in[i] = (const float*)d_in[i];
    a.out = (float*)d_out; a.ws = ws; a.ph_lo = 0; a.ph_hi = PH_END;
    hipLaunchKernelGGL(mega, dim3(grid), dim3(NWAVES * 64), LDS_BYTES, stream, a);
}
```

```cpp
#include <hip/hip_runtime.h>
#include <cstdio>
#include <cstdint>
#include <math.h>
#ifndef REP_PRO
#define REP_PRO 1
#endif
#ifndef REP_DENSE
#define REP_DENSE 1
#endif
#ifndef REP_MOEGU
#define REP_MOEGU 1
#endif
#ifndef REP_MOEDN
#define REP_MOEDN 1
#endif
#ifndef REP_ATTA
#define REP_ATTA 1
#endif
#ifndef REP_ATTBC
#define REP_ATTBC 1
#endif
#ifndef PROBE_STAMP
#define PROBE_STAMP -1
#endif
#ifndef PROBE_THR
#define PROBE_THR 1e-4f
#endif
namespace pg8 {
#define PG8_LAS __attribute__((address_space(3)))
typedef unsigned short bf16_t;
typedef short bf16x8 __attribute__((ext_vector_type(8)));
typedef float f32x4 __attribute__((ext_vector_type(4)));
typedef unsigned u32x4 __attribute__((ext_vector_type(4)));
constexpr int BM = 256, BK = 64, HALF = 128, HTB = HALF * BK * 2  , STAGE_BYTES = 8 * HTB, NXCD = 8, WGM = 8;

__host__ __device__ __forceinline__ int lds_byte(int r, int c) { const int st = (r >> 4) * 2 + (c >> 5), rr = r & 15, cc = c & 31, ob = rr * 64 + cc * 2; return st * 1024 + (ob ^ (((ob >> 9) & 1) << 5)); }
__host__ __device__ __forceinline__ void stage_rc(int b, int& R, int& C) { const int st = b / 1024, sb = b % 1024, swz = sb ^ (((sb >> 9) & 1) << 5); R = (st >> 1) * 16 + swz / 64; C = (st & 1) * 32 + (swz % 64) / 2; }
__host__ __device__ __forceinline__ int perm32(int rho) { const int n = rho >> 4, i = rho & 15; return 8 * (i >> 2) + 4 * n + (i & 3); }

struct Unit { int pm, pn; };
struct Gemm { const bf16_t* A; const bf16_t* Bt; int M, N, K; };

struct StaticOrder {
    int nM, nN, nwg, G, c;
    __host__ __device__ void init(int M, int N, int G_, int c_) { nM = M / BM; nN = N / BM; nwg = nM * nN; G = G_; c = c_; }
    __host__ __device__ bool next(int i, Unit& u) const {
        const long L = (long)i * G + c; if (L >= nwg) return false;
        int wgid = (int)L; { const int q = nwg / NXCD, r = nwg % NXCD, xcd = wgid % NXCD, off = wgid / NXCD; wgid = (xcd < r ? xcd * (q + 1) : r * (q + 1) + (xcd - r) * q) + off; }
        const int nig = WGM * nN, gid = wgid / nig, fm = gid * WGM, gsz = (nM - fm) < WGM ? (nM - fm) : WGM;
        u.pm = fm + ((wgid % nig) % gsz); u.pn = (wgid % nig) / gsz; return true;
    }
    __device__ __forceinline__ void a_ready(const Unit&) const {}
    __device__ __forceinline__ void done(const Unit&) const {}
};

__device__ __forceinline__ unsigned cvt_pk_bf16(float lo, float hi) { unsigned r; asm volatile("v_cvt_pk_bf16_f32 %0, %1, %2" : "=v"(r) : "v"(lo), "v"(hi)); return r; }
typedef float f32x2 __attribute__((ext_vector_type(2)));
__device__ __forceinline__ f32x2 gelu_pk(f32x2 v) {
    const f32x2 av = __builtin_elementwise_abs(v), d = av * 0.2316418882f + 1.0f;
    f32x2 t; t.x = __builtin_amdgcn_rcpf(d.x); t.y = __builtin_amdgcn_rcpf(d.y);
    f32x2 q = t * 0.5307027145f + (-0.7265760135f); q = q * t + 0.7107068705f; q = q * t + (-0.142248368f); q = q * t + 0.127414796f; q = q * t;
    const f32x2 s = (v * v) * (-0.72134752044f);
    f32x2 e; e.x = __builtin_amdgcn_exp2f(s.x); e.y = __builtin_amdgcn_exp2f(s.y);
    const f32x2 m = v * (q * e), r = v - m;
    f32x2 o; o.x = v.x < 0.f ? m.x : r.x; o.y = v.y < 0.f ? m.y : r.y; return o;
}

constexpr float LOG2E = 1.4426950408889634f;
constexpr float QSCALE_A = 0.17677669529663687f * LOG2E;
constexpr float QSCALE_BC = 0.125f * LOG2E;
struct EpiQKV {
    static constexpr bool PERM = true, AFTER_DRAIN = false;
    bf16_t* O; const float* ropeA; const float* ropeB;
    __device__ __forceinline__ void operator()(const f32x4 (&acc)[2][2][4][2], const Unit& u, int wr, int wc, int fr, int fq) const {
        const int row0 = u.pm * BM + wr * 64 + fr;
#pragma unroll
        for (int bj = 0; bj < 2; ++bj) {
            const int c0 = u.pn * BM + bj * HALF + wc * 32 + 8 * fq;
            int mode = 0, j0 = 0; float sc = 1.f;
            if (c0 < 512) { if ((c0 & 31) == 0) mode = 1; if (c0 < 256) sc = QSCALE_A; }
            else if (c0 >= 768 && c0 < 1536) { const int ho = (c0 - 768) & 63; if (ho == 0) { mode = 2; j0 = 0; } else if (ho == 8) { mode = 2; j0 = 4; } if (c0 < 1152) sc = QSCALE_BC; }
            else if (c0 >= 1920 && c0 < 2304) sc = QSCALE_BC;
            f32x4 cc[2][4], sn[2][4];
            if (mode != 0) { const float* tb = (mode == 1) ? ropeA : ropeB + j0; const int ts = (mode == 1) ? 8 : 16, so = (mode == 1) ? 4 : 8;
#pragma unroll
                for (int ai = 0; ai < 2; ++ai)
#pragma unroll
                    for (int m = 0; m < 4; ++m) { const int pos = (row0 + ai * HALF + m * 16) & 2047; cc[ai][m] = *(const f32x4*)(tb + pos * ts); sn[ai][m] = *(const f32x4*)(tb + pos * ts + so); } }
#pragma unroll
            for (int ai = 0; ai < 2; ++ai)
#pragma unroll
                for (int m = 0; m < 4; ++m) {
                    const int row = row0 + ai * HALF + m * 16;
                    f32x4 v0 = acc[ai][bj][m][0], v1 = acc[ai][bj][m][1];
                    if (mode != 0) { const f32x4 a = v0 * cc[ai][m] - v1 * sn[ai][m], b = v1 * cc[ai][m] + v0 * sn[ai][m]; v0 = a; v1 = b; }
                    v0 = v0 * sc; v1 = v1 * sc;
                    u32x4 w; w.x = cvt_pk_bf16(v0[0], v0[1]); w.y = cvt_pk_bf16(v0[2], v0[3]); w.z = cvt_pk_bf16(v1[0], v1[1]); w.w = cvt_pk_bf16(v1[2], v1[3]);
                    *(u32x4*)(O + (size_t)row * 3072 + c0) = w;
                }
        }
    }
};
struct EpiStoreBf16 {
    static constexpr bool PERM = true, AFTER_DRAIN = false;
    bf16_t* O; int ldc; int pm_off; int pn_mod;
    __device__ __forceinline__ void operator()(const f32x4 (&acc)[2][2][4][2], const Unit& u, int wr, int wc, int fr, int fq) const {
        const int row0 = (u.pm + pm_off) * BM + wr * 64 + fr; const int col0 = (u.pn % pn_mod) * BM + wc * 32 + 8 * fq;
#pragma unroll
        for (int ai = 0; ai < 2; ++ai)
#pragma unroll
            for (int m = 0; m < 4; ++m) { bf16_t* rowp = O + (size_t)(row0 + ai * HALF + m * 16) * ldc + col0;
#pragma unroll
                for (int bj = 0; bj < 2; ++bj) { const f32x4 v0 = acc[ai][bj][m][0], v1 = acc[ai][bj][m][1];
                    u32x4 w; w.x = cvt_pk_bf16(v0[0], v0[1]); w.y = cvt_pk_bf16(v0[2], v0[3]); w.z = cvt_pk_bf16(v1[0], v1[1]); w.w = cvt_pk_bf16(v1[2], v1[3]);
                    *(u32x4*)(rowp + bj * HALF) = w; } }
    }
};
struct EpiSwiglu {
    static constexpr bool PERM = true, AFTER_DRAIN = false;
    bf16_t* O; int ldc; int pm_off; int pn_mod;
    __device__ __forceinline__ void operator()(const f32x4 (&acc)[2][2][4][2], const Unit& u, int wr, int wc, int fr, int fq) const {
        const int row0 = (u.pm + pm_off) * BM + wr * 64 + fr; const int col0 = (u.pn % pn_mod) * HALF + wc * 32 + 8 * fq;
#pragma unroll
        for (int ai = 0; ai < 2; ++ai)
#pragma unroll
            for (int m = 0; m < 4; ++m) {
                float h[8];
#pragma unroll
                for (int n = 0; n < 2; ++n)
#pragma unroll
                    for (int j = 0; j < 4; ++j) { const float g = acc[ai][0][m][n][j], up = acc[ai][1][m][n][j];
                        const float e = __builtin_amdgcn_exp2f(-g * LOG2E); h[n * 4 + j] = g * __builtin_amdgcn_rcpf(1.0f + e) * up; }
                u32x4 w; w.x = cvt_pk_bf16(h[0], h[1]); w.y = cvt_pk_bf16(h[2], h[3]); w.z = cvt_pk_bf16(h[4], h[5]); w.w = cvt_pk_bf16(h[6], h[7]);
                *(u32x4*)(O + (size_t)(row0 + ai * HALF + m * 16) * ldc + col0) = w;
            }
    }
};
struct GroupedOrder {
    int ntiles, tile0, NP, G, c, a_rel; const int* tile_expert;
    __device__ __forceinline__ bool next(int i, Unit& u) const {
        const long L = (long)i * G + c; if (L >= (long)ntiles * NP) return false;
        const int g = (int)(L / (8 * NP)), r = (int)(L % (8 * NP)); const int rem = ntiles - 8 * g, gsz = rem < 8 ? rem : 8;
        const int pnl = r / gsz, t = 8 * g + (r % gsz);
        const int e = __builtin_amdgcn_readfirstlane(tile_expert[tile0 + t]);
        u.pm = a_rel ? t : tile0 + t; u.pn = e * NP + pnl; return true;
    }
    __device__ __forceinline__ void a_ready(const Unit&) const {}
    __device__ __forceinline__ void done(const Unit&) const {}
};
template <class Epi, class Sched, bool ALIGN_EPI = false, bool SP2 = false>
__device__ __forceinline__ void gemm_phase(PG8_LAS unsigned char* lds, const Gemm g, const Sched& S, const Epi& E) {
    int tid_ = threadIdx.x; asm volatile("" : "+v"(tid_));
    const int tid = tid_, wid = __builtin_amdgcn_readfirstlane(tid >> 6), lane = tid & 63, wr = wid >> 2, wc = wid & 3, fr = lane & 15, fq = lane >> 4;
    const int K = g.K, nt = K / BK;
    unsigned voffA[2], voffB[2];
#pragma unroll
    for (int i = 0; i < 2; ++i) { int R, C; stage_rc(tid * 16 + i * 8192, R, C); const int Rb = Epi::PERM ? ((R & ~31) + perm32(R & 31)) : R;
        voffA[i] = (unsigned)(R * K + C) * 2u; voffB[i] = (unsigned)(Rb * K + C) * 2u; }
    const size_t kstep = (size_t)(BK * 2);
    const size_t hstep = (size_t)HALF * K * 2;
    const size_t tstep = 2 * hstep;
    const unsigned ldsw = (unsigned)wid * 1024u;
    const int aoff = lds_byte(wr * 64 + fr, fq * 8), boff = lds_byte(wc * 32 + fr, fq * 8);
#define PG8_SA(b, h) (((b) * 2 + (h)) * HTB)
#define PG8_SB(b, h) ((4 + (b) * 2 + (h)) * HTB)
#define PG8_STAGE(bufoff, gbase, voff) do { _Pragma("unroll") for (int _i = 0; _i < 2; ++_i) \
        __builtin_amdgcn_global_load_lds((const unsigned*)((const char*)(gbase) + (voff)[_i]), (PG8_LAS unsigned*)(lds + (bufoff) + ldsw + _i * 8192), 16, 0, 0); } while (0)
#define PG8_LDA(dst, b, h) do { _Pragma("unroll") for (int m = 0; m < 4; ++m) _Pragma("unroll") for (int k = 0; k < 2; ++k) dst[m][k] = *(const PG8_LAS bf16x8*)(lds + PG8_SA(b, h) + aoff + m * 2048 + k * 1024); } while (0)
#define PG8_LDB(dst, b, h) do { _Pragma("unroll") for (int n = 0; n < 2; ++n) _Pragma("unroll") for (int k = 0; k < 2; ++k) dst[n][k] = *(const PG8_LAS bf16x8*)(lds + PG8_SB(b, h) + boff + n * 2048 + k * 1024); } while (0)
#define PG8_MMA(ai, bj, At, Bt) do { __builtin_amdgcn_s_setprio(1); _Pragma("unroll") for (int m = 0; m < 4; ++m) _Pragma("unroll") for (int n = 0; n < 2; ++n) _Pragma("unroll") for (int k = 0; k < 2; ++k) \
        acc[ai][bj][m][n] = __builtin_amdgcn_mfma_f32_16x16x32_bf16(Bt[n][k], At[m][k], acc[ai][bj][m][n], 0, 0, 0); __builtin_amdgcn_s_setprio(0); } while (0)
#define PG8_WAIT_V(n) asm volatile("s_waitcnt vmcnt(" #n ")" ::: "memory")
#define PG8_WAIT_L(n) asm volatile("s_waitcnt lgkmcnt(" #n ")" ::: "memory")
#define PG8_BAR __builtin_amdgcn_s_barrier()
#define PG8_SCHED __builtin_amdgcn_sched_barrier(0)
    Unit cur, nxt; int ui = 0;
    if (!S.next(0, cur)) return;
    f32x4 acc[2][2][4][2];
#pragma unroll
    for (int a = 0; a < 2; ++a)
#pragma unroll
        for (int b = 0; b < 2; ++b)
#pragma unroll
            for (int m = 0; m < 4; ++m)
#pragma unroll
                for (int n = 0; n < 2; ++n) acc[a][b][m][n] = (f32x4){0.f, 0.f, 0.f, 0.f};
    bf16x8 At[4][2], B0[2][2], B1[2][2];
    const char* cA = (const char*)g.A + (size_t)cur.pm * tstep; const char* cB = (const char*)g.Bt + (size_t)cur.pn * tstep;
    S.a_ready(cur);
    if constexpr (SP2) {
        PG8_STAGE(PG8_SB(0, 0), cB, voffB); PG8_STAGE(PG8_SB(0, 1), cB + hstep, voffB); PG8_STAGE(PG8_SA(0, 0), cA, voffA); PG8_STAGE(PG8_SA(0, 1), cA + hstep, voffA);
        if (wr == 1) PG8_BAR;
        PG8_WAIT_V(2); PG8_BAR;
        PG8_STAGE(PG8_SB(1, 0), cB + kstep, voffB); PG8_STAGE(PG8_SA(1, 0), cA + kstep, voffA); PG8_STAGE(PG8_SB(1, 1), cB + hstep + kstep, voffB);
        PG8_WAIT_V(6); PG8_BAR;
    } else {
        PG8_STAGE(PG8_SB(0, 0), cB, voffB); PG8_STAGE(PG8_SA(0, 0), cA, voffA); PG8_STAGE(PG8_SB(0, 1), cB + hstep, voffB); PG8_STAGE(PG8_SA(0, 1), cA + hstep, voffA);
        if (wr == 1) PG8_BAR;
        PG8_WAIT_V(4); PG8_BAR;
        PG8_STAGE(PG8_SB(1, 0), cB + kstep, voffB); PG8_STAGE(PG8_SA(1, 0), cA + kstep, voffA); PG8_STAGE(PG8_SB(1, 1), cB + hstep + kstep, voffB);
        PG8_WAIT_V(6); PG8_BAR;
    }
    for (;;) {
        const bool has_next = S.next(ui + 1, nxt);
        const char* nA = has_next ? (const char*)g.A + (size_t)nxt.pm * tstep : cA; const char* nB = has_next ? (const char*)g.Bt + (size_t)nxt.pn * tstep : cB;
        for (int t = 0; t < nt; t += 2) {
            const bool last = (t == nt - 2);
            const char* a1 = cA + (size_t)(t + 1) * kstep;
            const char* a2 = last ? nA : cA + (size_t)(t + 2) * kstep; const char* b2 = last ? nB : cB + (size_t)(t + 2) * kstep;
            const char* a3 = a2 + kstep; const char* b3 = b2 + kstep;
            if (last && has_next) S.a_ready(nxt);
            if constexpr (SP2) {
            PG8_LDB(B0, 0, 0); PG8_LDB(B1, 0, 1); PG8_SCHED; PG8_LDA(At, 0, 0); PG8_STAGE(PG8_SA(1, 1), a1 + hstep, voffA);
            PG8_WAIT_V(8); PG8_WAIT_L(0); PG8_BAR; PG8_MMA(0, 0, At, B0); PG8_MMA(0, 1, At, B1); PG8_BAR; PG8_SCHED;
            PG8_LDA(At, 0, 1); PG8_STAGE(PG8_SB(0, 0), b2, voffB); PG8_STAGE(PG8_SB(0, 1), b2 + hstep, voffB); PG8_STAGE(PG8_SA(0, 0), a2, voffA);
            PG8_WAIT_V(8); PG8_WAIT_L(0); PG8_BAR; PG8_MMA(1, 0, At, B0); PG8_MMA(1, 1, At, B1); PG8_BAR; PG8_SCHED;
            PG8_LDB(B0, 1, 0); PG8_LDB(B1, 1, 1); PG8_SCHED; PG8_LDA(At, 1, 0); PG8_STAGE(PG8_SA(0, 1), a2 + hstep, voffA);
            PG8_WAIT_V(8); PG8_WAIT_L(0); PG8_BAR; PG8_MMA(0, 0, At, B0); PG8_MMA(0, 1, At, B1); PG8_BAR; PG8_SCHED;
            PG8_LDA(At, 1, 1); PG8_STAGE(PG8_SB(1, 0), b3, voffB); PG8_STAGE(PG8_SB(1, 1), b3 + hstep, voffB); PG8_STAGE(PG8_SA(1, 0), a3, voffA);
            PG8_WAIT_V(8); PG8_WAIT_L(0); PG8_BAR; PG8_MMA(1, 0, At, B0); PG8_MMA(1, 1, At, B1); PG8_BAR; PG8_SCHED;
            } else {
            PG8_LDB(B0, 0, 0); PG8_SCHED; PG8_LDA(At, 0, 0); PG8_STAGE(PG8_SA(1, 1), a1 + hstep, voffA);
            PG8_WAIT_L(8); PG8_BAR; PG8_WAIT_L(0); PG8_MMA(0, 0, At, B0); PG8_BAR; PG8_SCHED;
            PG8_LDB(B1, 0, 1); PG8_STAGE(PG8_SB(0, 0), b2, voffB);
            PG8_BAR; PG8_WAIT_L(0); PG8_MMA(0, 1, At, B1); PG8_BAR;
            PG8_LDA(At, 0, 1); PG8_STAGE(PG8_SA(0, 0), a2, voffA);
            PG8_BAR; PG8_WAIT_L(0); PG8_MMA(1, 0, At, B0); PG8_BAR; PG8_SCHED;
            PG8_STAGE(PG8_SB(0, 1), b2 + hstep, voffB);
            PG8_WAIT_V(6); PG8_BAR; PG8_MMA(1, 1, At, B1); PG8_BAR;
            PG8_LDB(B0, 1, 0); PG8_SCHED; PG8_LDA(At, 1, 0); PG8_STAGE(PG8_SA(0, 1), a2 + hstep, voffA);
            PG8_WAIT_L(8); PG8_BAR; PG8_WAIT_L(0); PG8_MMA(0, 0, At, B0); PG8_BAR; PG8_SCHED;
            PG8_LDB(B1, 1, 1); PG8_STAGE(PG8_SB(1, 0), b3, voffB);
            PG8_BAR; PG8_WAIT_L(0); PG8_MMA(0, 1, At, B1); PG8_BAR;
            PG8_LDA(At, 1, 1); PG8_STAGE(PG8_SA(1, 0), a3, voffA);
            PG8_BAR; PG8_WAIT_L(0); PG8_MMA(1, 0, At, B0); PG8_BAR; PG8_SCHED;
            PG8_STAGE(PG8_SB(1, 1), b3 + hstep, voffB);
            PG8_WAIT_V(6); PG8_BAR; PG8_MMA(1, 1, At, B1); PG8_BAR;
            }
        }
        if constexpr (ALIGN_EPI) { if (wr == 0) PG8_BAR; }
        if constexpr (!Epi::AFTER_DRAIN) { E(acc, cur, wr, wc, fr, fq); S.done(cur); }
        if (!has_next) break;
#pragma unroll
        for (int a = 0; a < 2; ++a)
#pragma unroll
            for (int b = 0; b < 2; ++b)
#pragma unroll
                for (int m = 0; m < 4; ++m)
#pragma unroll
                    for (int n = 0; n < 2; ++n) acc[a][b][m][n] = (f32x4){0.f, 0.f, 0.f, 0.f};
        cur = nxt; cA = nA; cB = nB; ++ui;
        if constexpr (ALIGN_EPI) { if (wr == 1) PG8_BAR; }
    }
    PG8_WAIT_V(0);
    if constexpr (!ALIGN_EPI) { if (wr == 0) PG8_BAR; }
    PG8_BAR;
    if constexpr (Epi::AFTER_DRAIN) { E.fused(acc, cur, wr, wc, fr, fq, lds, wid, lane); S.done(cur); }
#undef PG8_SA
#undef PG8_SB
#undef PG8_STAGE
#undef PG8_LDA
#undef PG8_LDB
#undef PG8_MMA
#undef PG8_WAIT_V
#undef PG8_WAIT_L
#undef PG8_BAR
#undef PG8_SCHED
}
}
namespace mk {
constexpr int NWAVES = 8;
constexpr int D = 1024, BATCH = 8, SEQ = 2048, M = BATCH * SEQ, DEPTH = 2, NQKV = 3072;
constexpr int DFF = 2816, NEXP = 8, DFE = 3584;
constexpr int TMAX = 136;
constexpr int PASS0_TILES = 64, HMOE_TILES = 72;
constexpr float LN_EPS = 1e-5f;
constexpr float ALPHA = 1.41421356237309515f;
constexpr float ROPE_THETA = 500000.0f;
constexpr float LOG2E = 1.4426950408889634f;

constexpr size_t MiB = 1u << 20;
constexpr size_t WS_CTL = 0, CTL_ZERO_BYTES = 1 * MiB;
constexpr size_t WS_TAB = 2 * MiB;
constexpr size_t WS_WMGU = 4 * MiB;
constexpr size_t WS_WMDN = WS_WMGU + 112 * MiB;
constexpr size_t WS_XBF = WS_WMDN + 56 * MiB;
constexpr size_t WS_R = WS_XBF + 32 * MiB;
constexpr size_t R_QKV = 0;
constexpr size_t R_O = 96 * MiB;
constexpr size_t R_MIX = 128 * MiB;
constexpr size_t R_H = 0;
constexpr size_t R_F = 96 * MiB;
constexpr size_t R_XS = 0;
constexpr size_t R_HM = 68 * MiB;
constexpr size_t R_WSMALL = 160 * MiB;
constexpr size_t R_WIN = R_WSMALL;
constexpr size_t R_WOUT = R_WIN + 12 * MiB;
constexpr size_t R_WGU = R_WOUT + 4 * MiB;
constexpr size_t R_WDN = R_WGU + 11 * MiB;
constexpr size_t R_SIZE = 194 * MiB;
constexpr size_t WS_END = WS_R + R_SIZE;
static_assert(R_WDN + (size_t)D * DFF * 2 <= R_SIZE && R_HM + (size_t)HMOE_TILES * 256 * DFE * 2 <= R_SIZE && (size_t)TMAX * 256 * D * 2 <= R_HM, "R map");
constexpr size_t T_ROPEA = 0;
constexpr size_t T_ROPEB = 64 * 1024;
constexpr size_t T_TOKE = 256 * 1024;
constexpr size_t T_TOKS = T_TOKE + 128 * 1024;
constexpr size_t T_TOKG = T_TOKS + 128 * 1024;
constexpr size_t T_TILEE = T_TOKG + 128 * 1024;
constexpr int CW_CNT = 1024;
constexpr int CW_BAR = 4096;

constexpr int RING_BYTES = 131072;
constexpr int MISC_OFF = RING_BYTES + 320;
constexpr int LDS_BYTES = 147456;

#define GAS __attribute__((address_space(1)))
#define LAS __attribute__((address_space(3)))
typedef unsigned short bf16;
typedef unsigned v4u __attribute__((ext_vector_type(4)));
typedef unsigned v2u __attribute__((ext_vector_type(2)));
typedef float f32x4 __attribute__((ext_vector_type(4)));
typedef float f32x16 __attribute__((ext_vector_type(16)));
typedef short bf16x8 __attribute__((ext_vector_type(8)));
typedef short s16x4 __attribute__((ext_vector_type(4)));
typedef GAS unsigned gu32;
#define RLX_AGENT __ATOMIC_RELAXED, __HIP_MEMORY_SCOPE_AGENT
#define LDS_WAIT() asm volatile("s_waitcnt lgkmcnt(0)" ::: "memory")
#define VM_WAIT() asm volatile("s_waitcnt vmcnt(0)" ::: "memory")
__device__ __forceinline__ unsigned f2bf(float f) { unsigned u = __builtin_bit_cast(unsigned, f); return (u + 0x7fffu + ((u >> 16) & 1u)) >> 16; }
__device__ __forceinline__ unsigned pk2(float lo, float hi) { return f2bf(lo) | (f2bf(hi) << 16); }
__device__ __forceinline__ float bflo(unsigned w) { return __builtin_bit_cast(float, w << 16); }
__device__ __forceinline__ float bfhi(unsigned w) { return __builtin_bit_cast(float, w & 0xffff0000u); }

#define XB_TMO      128
#define XB_XCNT(j)  (256  + 64 * (j))
#define XB_XSUB(j)  (1280 + 64 * (j))
#define XB_XGEN(j)  (2304 + 64 * (j))
#define XB_TOP      3328
#define XB_TOPGEN   3392
#define XCD_BAR_WORDS 3456
#define XB_SPIN_CAP (1u << 18)
__device__ __forceinline__ unsigned xb_ld(unsigned* p)              { return __hip_atomic_load(p, __ATOMIC_RELAXED, __HIP_MEMORY_SCOPE_AGENT); }
__device__ __forceinline__ unsigned xb_add(unsigned* p, unsigned v) { return __hip_atomic_fetch_add(p, v, __ATOMIC_RELAXED, __HIP_MEMORY_SCOPE_AGENT); }
__device__ __forceinline__ unsigned xb_xcc_id() { return (unsigned)__builtin_amdgcn_s_getreg((3 << 11) | 20) & 0xFu; }
#define XB_SPIN(cond, bar) do { unsigned _sp = 0; while (cond) { __builtin_amdgcn_s_sleep(1); \
    if ((++_sp & 255u) == 0u) { if (xb_ld(&(bar)[XB_TMO])) break; if (_sp > XB_SPIN_CAP) { atomicAdd(&(bar)[XB_TMO], 1u); break; } } } } while (0)
struct XcdBarrier { unsigned* bar; unsigned x; volatile LAS unsigned* st; };
__device__ __forceinline__ XcdBarrier xcd_barrier_post(unsigned* bar, volatile LAS unsigned* st) {
    XcdBarrier b; b.bar = bar; b.x = xb_xcc_id(); b.st = st;
    if (threadIdx.x == 0) (void)xb_add(&bar[XB_XCNT(b.x)], 1u);
    return b;
}
__device__ __forceinline__ void xcd_barrier_complete(unsigned* bar, unsigned x, unsigned& nloc, unsigned& nx) {
    const unsigned G = gridDim.x * gridDim.y * gridDim.z;
    unsigned sum, cnt, mine, sp = 0u;
    for (;;) {
        sum = 0u; cnt = 0u; mine = 0u;
#pragma unroll
        for (unsigned j = 0; j < 16; ++j) { const unsigned c = xb_ld(&bar[XB_XCNT(j)]); sum += c; cnt += (c > 0u) ? 1u : 0u; mine = (j == x) ? c : mine; }
        if (sum == G) break;
        __builtin_amdgcn_s_sleep(1);
        if ((++sp & 255u) == 0u) { if (xb_ld(&bar[XB_TMO])) break; if (sp > XB_SPIN_CAP) { atomicAdd(&bar[XB_TMO], 1u); break; } }
    }
    nloc = mine > 0u ? mine : 1u; nx = cnt > 0u ? cnt : 1u;
}
__device__ __forceinline__ void xcd_barrier(const XcdBarrier& b) {
    asm volatile("s_waitcnt vmcnt(0)" ::: "memory");
    __syncthreads();
    if (threadIdx.x == 0) {
        unsigned* bar = b.bar;
        __builtin_amdgcn_s_waitcnt(0);
        unsigned nloc = b.st[0], nx = b.st[1];
        if (nloc == 0u) { xcd_barrier_complete(bar, b.x, nloc, nx); b.st[0] = nloc; b.st[1] = nx; }
        const unsigned old = xb_add(&bar[XB_XSUB(b.x)], 1u);
        const unsigned gen = old / nloc;
        if (old + 1u == (gen + 1u) * nloc) {
            __builtin_amdgcn_fence(__ATOMIC_RELEASE, "agent");
            asm volatile("s_waitcnt vmcnt(0)" ::: "memory");
            const unsigned og = xb_add(&bar[XB_TOP], 1u);
            const unsigned tg = og / nx;
            if (og + 1u == (tg + 1u) * nx) xb_add(&bar[XB_TOPGEN], 1u);
            else XB_SPIN(xb_ld(&bar[XB_TOPGEN]) == tg, bar);
            __builtin_amdgcn_fence(__ATOMIC_ACQUIRE, "agent");
            xb_add(&bar[XB_XGEN(b.x)], 1u);
            asm volatile("s_waitcnt vmcnt(0)" ::: "memory");
        } else {
            XB_SPIN(xb_ld(&bar[XB_XGEN(b.x)]) == gen, bar);
            __builtin_amdgcn_fence(__ATOMIC_ACQUIRE, "agent");
            asm volatile("s_waitcnt vmcnt(0)" ::: "memory");
        }
    }
    __syncthreads();
}

__device__ __forceinline__ float wave_sum(float v) {
#pragma unroll
    for (int o = 1; o < 64; o <<= 1) v += __shfl_xor(v, o);
    return v;
}

__device__ __forceinline__ int map_row(int mode, int n) {
    if (mode == 1) { if (n >= 768 && n < 1536) { const int d = (n - 768) & 63; if (d >= 4 && d < 8) n += 4; else if (d >= 8 && d < 12) n -= 4; } return n; }
    if (mode == 2) return (n >> 7) * 256 + (n & 127);
    if (mode == 3) return (n >> 7) * 256 + 128 + (n & 127);
    return n;
}
struct TItem { const float* W; bf16* WT; const float* ks; int K, N, mode, item; };
__device__ __forceinline__ void titem_load(const TItem& t, f32x4 (&r)[8], int lane) {
    const int nblk = t.N / 32, kb = t.item / nblk, nb = t.item % nblk;
    const float* src = t.W + (size_t)(64 * kb + (lane >> 3)) * t.N + 32 * nb + 4 * (lane & 7);
#pragma unroll
    for (int i = 0; i < 8; ++i) r[i] = *(const GAS f32x4*)(src + (size_t)(8 * i) * t.N);
}
__device__ __forceinline__ void titem_to_lds(const TItem& t, const f32x4 (&r)[8], LAS float* scr, int lane) {
    const int nblk = t.N / 32, kb = t.item / nblk;
#pragma unroll
    for (int i = 0; i < 8; ++i) { const int kk = 8 * i + (lane >> 3); const float sc = t.ks ? t.ks[64 * kb + kk] : 1.0f; LAS float* d = scr + kk * 33 + 4 * (lane & 7);
        d[0] = r[i].x * sc; d[1] = r[i].y * sc; d[2] = r[i].z * sc; d[3] = r[i].w * sc; }
}
__device__ __forceinline__ void titem_store(const TItem& t, LAS float* scr, int lane) {
    const int nblk = t.N / 32, kb = t.item / nblk, nb = t.item % nblk, k0 = 64 * kb, n0 = 32 * nb;
    const int c = lane & 7;
#pragma unroll
    for (int j = 0; j < 4; ++j) { const int n = (lane >> 3) + 8 * j; const LAS float* s = scr + (8 * c) * 33 + n;
        v4u o; o.x = pk2(s[0 * 33], s[1 * 33]); o.y = pk2(s[2 * 33], s[3 * 33]); o.z = pk2(s[4 * 33], s[5 * 33]); o.w = pk2(s[6 * 33], s[7 * 33]);
        *(GAS v4u*)(t.WT + (size_t)map_row(t.mode, n0 + n) * t.K + k0 + 8 * c) = o; }
}
template <int YMODE, bool ROUTER, bool RES_BF, bool WRITE_F32, bool WRITE_BF>
__device__ __forceinline__ void ln_phase(const void* resid, const bf16* Y0, const int* tok_pair, const float* tok_gate, const float* gam, const float* bet, float* out, bf16* xbf,
                                         const float* wr, gu32* cnt, int* tok_e, int* tok_s, float* tok_g, LAS unsigned char* L, int gw, int NGW, int lane) {
    int tidx = threadIdx.x; asm volatile("" : "+v"(lane), "+v"(tidx));
    LAS float* wrT = (LAS float*)L;
    LAS unsigned* cntl = (LAS unsigned*)(L + 32768);
    LAS int* rec = (LAS int*)(L + 32768 + 64) + (tidx >> 6) * (6 * 64);
    if (ROUTER) { for (int i = tidx; i < D * NEXP; i += NWAVES * 64) wrT[(i & 7) * D + (i >> 3)] = wr[i]; if (tidx < 16) cntl[tidx] = 0u; __syncthreads(); }
    int nrow = 0;
    f32x4 gv[4], bv[4];
#pragma unroll
    for (int j = 0; j < 4; ++j) { gv[j] = *(const f32x4*)(gam + 4 * lane + 256 * j); bv[j] = *(const f32x4*)(bet + 4 * lane + 256 * j); }
    for (int m = gw; m < M; m += NGW) {
        f32x4 xres[4];
        if (RES_BF) { const GAS v2u* xr = (const GAS v2u*)((const bf16*)resid + (size_t)m * D) + lane;
#pragma unroll
            for (int j = 0; j < 4; ++j) { const v2u w = xr[64 * j]; xres[j] = (f32x4){bflo(w.x), bfhi(w.x), bflo(w.y), bfhi(w.y)}; } }
        else { const GAS f32x4* xr = (const GAS f32x4*)((const float*)resid + (size_t)m * D) + lane;
#pragma unroll
            for (int j = 0; j < 4; ++j) xres[j] = xr[64 * j]; }
        f32x4 v[4]; float s = 0.f;
        if (YMODE == 0) {
            const GAS v2u* yr = (const GAS v2u*)(Y0 + (size_t)m * D) + lane;
#pragma unroll
            for (int j = 0; j < 4; ++j) { const f32x4 x = xres[j]; const v2u w = yr[64 * j]; v[j].x = ALPHA * x.x + bflo(w.x); v[j].y = ALPHA * x.y + bfhi(w.x); v[j].z = ALPHA * x.z + bflo(w.y); v[j].w = ALPHA * x.w + bfhi(w.y); }
        } else {
            const int p0 = tok_pair[2 * m], p1 = tok_pair[2 * m + 1]; const float g0 = tok_gate[2 * m], g1 = tok_gate[2 * m + 1];
            const GAS v2u* y0 = (const GAS v2u*)(Y0 + (size_t)p0 * D) + lane; const GAS v2u* y1 = (const GAS v2u*)(Y0 + (size_t)p1 * D) + lane;
#pragma unroll
            for (int j = 0; j < 4; ++j) { const f32x4 x = xres[j]; const v2u a = y0[64 * j], b = y1[64 * j];
                v[j].x = ALPHA * x.x + (g0 * bflo(a.x) + g1 * bflo(b.x)); v[j].y = ALPHA * x.y + (g0 * bfhi(a.x) + g1 * bfhi(b.x));
                v[j].z = ALPHA * x.z + (g0 * bflo(a.y) + g1 * bflo(b.y)); v[j].w = ALPHA * x.w + (g0 * bfhi(a.y) + g1 * bfhi(b.y)); }
        }
#pragma unroll
        for (int j = 0; j < 4; ++j) s += (v[j].x + v[j].y) + (v[j].z + v[j].w);
        const float mean = wave_sum(s) * (1.f / D); float s2 = 0.f;
#pragma unroll
        for (int j = 0; j < 4; ++j) { v[j] = v[j] - mean; s2 += (v[j].x * v[j].x + v[j].y * v[j].y) + (v[j].z * v[j].z + v[j].w * v[j].w); }
        const float rstd = 1.0f / sqrtf(wave_sum(s2) * (1.f / D) + LN_EPS);
        GAS f32x4* orow = (GAS f32x4*)(out + (size_t)m * D) + lane; GAS v2u* brow = (GAS v2u*)(xbf + (size_t)m * D) + lane;
#pragma unroll
        for (int j = 0; j < 4; ++j) { v[j] = v[j] * rstd * gv[j] + bv[j]; if (WRITE_F32) orow[64 * j] = v[j]; if (WRITE_BF) { v2u w; w.x = pk2(v[j].x, v[j].y); w.y = pk2(v[j].z, v[j].w); brow[64 * j] = w; } }
        if (ROUTER) {
            float lg[8];
#pragma unroll
            for (int e = 0; e < 8; ++e) { float a = 0.f;
#pragma unroll
                for (int j = 0; j < 4; ++j) { const f32x4 w = *(const LAS f32x4*)(wrT + e * D + 4 * lane + 256 * j); a += (v[j].x * w.x + v[j].y * w.y) + (v[j].z * w.z + v[j].w * w.w); }
                lg[e] = wave_sum(a); }
            int i0 = 0;
#pragma unroll
            for (int e = 1; e < 8; ++e) if (lg[e] > lg[i0]) i0 = e;
            int i1 = (i0 == 0) ? 1 : 0;
#pragma unroll
            for (int e = 0; e < 8; ++e) if (e != i0 && lg[e] > lg[i1]) i1 = e;
            if (lane == 0) {
                const float e1 = expf(lg[i1] - lg[i0]); const float g0 = 1.f / (1.f + e1), g1 = e1 / (1.f + e1);
                const int s0 = (int)__hip_atomic_fetch_add(cntl + i0, 1u, __ATOMIC_RELAXED, __HIP_MEMORY_SCOPE_WORKGROUP); const int s1 = (int)__hip_atomic_fetch_add(cntl + i1, 1u, __ATOMIC_RELAXED, __HIP_MEMORY_SCOPE_WORKGROUP);
                LAS int* rc = rec + 6 * (nrow & 63); rc[0] = i0; rc[1] = i1; rc[2] = s0; rc[3] = s1; rc[4] = __float_as_int(g0); rc[5] = __float_as_int(g1);
            }
            ++nrow;
        }
    }
    if (ROUTER) {
        __syncthreads();
        if (tidx < 8) cntl[8 + tidx] = __hip_atomic_fetch_add(cnt + 64 * tidx, cntl[tidx], RLX_AGENT);
        __syncthreads();
        if (lane < nrow) { const int m = gw + lane * NGW; const LAS int* rc = rec + 6 * lane; const int i0 = rc[0], i1 = rc[1];
            tok_e[2 * m] = i0; tok_e[2 * m + 1] = i1; tok_s[2 * m] = (int)cntl[8 + i0] + rc[2]; tok_s[2 * m + 1] = (int)cntl[8 + i1] + rc[3];
            tok_g[2 * m] = __int_as_float(rc[4]); tok_g[2 * m + 1] = __int_as_float(rc[5]); }
    }
}
__device__ __forceinline__ void moe_gather(const gu32* cnt, const int* tok_e, int* tok_s, const bf16* xbf, bf16* Xs, int* tile_e, LAS unsigned char* L, int gw, int NGW, int lane) {
    int tidx = threadIdx.x; asm volatile("" : "+v"(lane), "+v"(tidx));
    LAS int* lb = (LAS int*)L;
    if (tidx == 0) { int acc = 0; for (int e = 0; e < 8; ++e) { const int c = (int)cnt[64 * e]; lb[e] = acc; lb[8 + e] = c; acc += (c + 255) & ~255; } lb[16] = acc >> 8; }
    __syncthreads();
    if (blockIdx.x == 0) { const int nt = lb[16]; for (int t = tidx; t < nt; t += NWAVES * 64) { int e = 0; for (int k = 1; k < 8; ++k) if (t * 256 >= lb[k]) e = k; tile_e[t] = e; } if (tidx == 0) tile_e[TMAX] = nt; }
    for (int m = gw; m < M; m += NGW) {
        const GAS v4u* src = (const GAS v4u*)(xbf + (size_t)m * D) + lane; const v4u a = src[0], b = src[64];
#pragma unroll
        for (int k = 0; k < 2; ++k) { const int e = tok_e[2 * m + k]; const int pr = lb[e] + tok_s[2 * m + k]; GAS v4u* dst = (GAS v4u*)(Xs + (size_t)pr * D) + lane; dst[0] = a; dst[64] = b; if (lane == 0) tok_s[2 * m + k] = pr; }
    }
    for (int e = 0; e < 8; ++e) { const int c = lb[8 + e], np = ((c + 255) & ~255) - c;
        for (int r = gw; r < np; r += NGW) { GAS v4u* dst = (GAS v4u*)(Xs + (size_t)(lb[e] + c + r) * D) + lane; dst[0] = (v4u){0u, 0u, 0u, 0u}; dst[64] = (v4u){0u, 0u, 0u, 0u}; } }
}
typedef short v4i16_t __attribute__((ext_vector_type(4)));
typedef float f32x2_t __attribute__((ext_vector_type(2))); typedef __bf16 bf16x2_t __attribute__((ext_vector_type(2)));
__device__ __forceinline__ int crow(int r, int hi) { return (r & 3) + 8 * (r >> 2) + 4 * hi; }
__device__ __forceinline__ unsigned cvtpk(float lo, float hi) { f32x2_t v = {lo, hi}; bf16x2_t b = __builtin_convertvector(v, bf16x2_t); return __builtin_bit_cast(unsigned, b); }
__device__ __forceinline__ float ex2(float x) { return __builtin_amdgcn_exp2f(x); }
__device__ __forceinline__ float xhalf(float x) { return __shfl_xor(x, 32); }
__device__ __forceinline__ bf16x8 vfrag(LAS unsigned char* p) {
    const v4i16_t lo = __builtin_amdgcn_ds_read_tr16_b64_v4i16((LAS v4i16_t*)p);
    const v4i16_t hi = __builtin_amdgcn_ds_read_tr16_b64_v4i16((LAS v4i16_t*)(p + 512));
    return (bf16x8){lo[0], lo[1], lo[2], lo[3], hi[0], hi[1], hi[2], hi[3]};
}
__device__ __forceinline__ bf16x8 pfrag(const unsigned* pw) { v4u t = {pw[0], pw[1], pw[2], pw[3]}; return __builtin_bit_cast(bf16x8, t); }
#define MFMA32(a, b, c) __builtin_amdgcn_mfma_f32_32x32x16_bf16((a), (b), (c), 0, 0, 0)

template <int NS>
__device__ __forceinline__ void softmax_update(f32x16 (&s)[NS], float& m, float& l, f32x16 (&O)[2], unsigned (&pw)[NS][8]) {
    float mx = s[0][0];
#pragma unroll
    for (int i = 0; i < NS; ++i)
#pragma unroll
        for (int r = 0; r < 16; ++r) mx = fmaxf(mx, s[i][r]);
    mx = fmaxf(mx, xhalf(mx));
    const float mn = fmaxf(m, mx);
    if (__any(mn > m)) { const float alpha = ex2(m - mn); l *= alpha;
#pragma unroll
        for (int d = 0; d < 2; ++d)
#pragma unroll
            for (int r = 0; r < 16; ++r) O[d][r] *= alpha; }
    m = mn;
    float rs = 0.f;
#pragma unroll
    for (int i = 0; i < NS; ++i) {
#pragma unroll
        for (int r = 0; r < 16; ++r) { s[i][r] = ex2(s[i][r] - mn); rs += s[i][r]; }
#pragma unroll
        for (int k = 0; k < 8; ++k) pw[i][k] = cvtpk(s[i][2 * k], s[i][2 * k + 1]);
    }
    l += rs;
}

constexpr int A_KBUF = 0, A_VBUF = 16384;
__device__ __forceinline__ void attn_a_unit(const bf16* QKV, bf16* Oout, int b, int h, int qblk, float lam, float lam_init, const float* ng, LAS unsigned char* L, int wave, int lane) {
    const int r32 = lane & 31, hi = lane >> 5;
    const size_t rowb = (size_t)b * SEQ;
    const bf16* qp = QKV + (rowb + qblk * 256 + wave * 32 + r32) * NQKV + h * 64 + 8 * hi;
    bf16x8 qf[2][2];
#pragma unroll
    for (int mp = 0; mp < 2; ++mp)
#pragma unroll
        for (int d0 = 0; d0 < 2; ++d0) qf[mp][d0] = *(const bf16x8*)(qp + 32 * mp + 16 * d0);
    const bf16* ksrc = QKV + (rowb + lane) * NQKV + 256 + h * 64 + wave * 8;
    const bf16* vsrc = QKV + (rowb + 16 * (wave & 3) + (lane >> 2)) * NQKV + 512 + h * 64 + 32 * (wave >> 2) + 8 * (lane & 3);
    LAS unsigned char* kdst = L + A_KBUF + wave * 1024 + lane * 16;
    LAS unsigned char* vdst = L + A_VBUF + wave * 1024 + lane * 16;
    LAS unsigned char* kfr = L + A_KBUF + hi * 1024 + r32 * 16;
    LAS unsigned char* vfr = L + A_VBUF + ((lane >> 4) & 1) * 32 + (lane & 3) * 8 + (4 * hi + ((lane & 15) >> 2)) * 64;
    f32x16 O[2][2]; float mrow[2], lrow[2];
#pragma unroll
    for (int mp = 0; mp < 2; ++mp) { mrow[mp] = -1e30f; lrow[mp] = 0.f;
#pragma unroll
        for (int d = 0; d < 2; ++d)
#pragma unroll
            for (int r = 0; r < 16; ++r) O[mp][d][r] = 0.f; }
    v4u kreg = *(const v4u*)ksrc, vreg = *(const v4u*)vsrc;
    *(LAS v4u*)kdst = kreg; *(LAS v4u*)vdst = vreg;
    __syncthreads();
    constexpr int NT = SEQ / 64;
    for (int t = 0; t < NT; ++t) {
        const int cur = (t & 1) * 8192, nxt = 8192 - cur;
        if (t + 1 < NT) { kreg = *(const v4u*)(ksrc + (size_t)(t + 1) * 64 * NQKV); vreg = *(const v4u*)(vsrc + (size_t)(t + 1) * 64 * NQKV); }
        unsigned pw[2][2][8];
#pragma unroll
        for (int mp = 0; mp < 2; ++mp) {
            f32x16 s[2];
#pragma unroll
            for (int r = 0; r < 16; ++r) { s[0][r] = 0.f; s[1][r] = 0.f; }
#pragma unroll
            for (int d0 = 0; d0 < 2; ++d0) {
                const bf16x8 k0 = *(LAS bf16x8*)(kfr + cur + (4 * mp + 2 * d0) * 1024), k1 = *(LAS bf16x8*)(kfr + cur + (4 * mp + 2 * d0) * 1024 + 512);
                s[0] = MFMA32(k0, qf[mp][d0], s[0]); s[1] = MFMA32(k1, qf[mp][d0], s[1]);
            }
            softmax_update<2>(s, mrow[mp], lrow[mp], O[mp], pw[mp]);
        }
#pragma unroll
        for (int ks = 0; ks < 4; ++ks)
#pragma unroll
            for (int d0 = 0; d0 < 2; ++d0) {
                const bf16x8 vf = vfrag(vfr + cur + d0 * 4096 + ks * 1024);
                O[0][d0] = MFMA32(vf, pfrag(&pw[0][ks >> 1][4 * (ks & 1)]), O[0][d0]);
                O[1][d0] = MFMA32(vf, pfrag(&pw[1][ks >> 1][4 * (ks & 1)]), O[1][d0]);
            }
        if (t + 1 < NT) { *(LAS v4u*)(kdst + nxt) = kreg; *(LAS v4u*)(vdst + nxt) = vreg; }
        __syncthreads();
    }
    const float i0 = 1.0f / (lrow[0] + xhalf(lrow[0])), i1 = lam / (lrow[1] + xhalf(lrow[1]));
    float ss = 0.f;
#pragma unroll
    for (int d = 0; d < 2; ++d)
#pragma unroll
        for (int r = 0; r < 16; ++r) { const float o = O[0][d][r] * i0 - O[1][d][r] * i1; O[0][d][r] = o; ss += o * o; }
    ss += xhalf(ss);
    const float rr = rsqrtf(ss * (1.0f / 64.0f) + LN_EPS) * (1.0f - lam_init);
    bf16* op = Oout + (rowb + qblk * 256 + wave * 32 + r32) * D + h * 64 + 4 * hi;
#pragma unroll
    for (int d = 0; d < 2; ++d)
#pragma unroll
        for (int g = 0; g < 4; ++g) { const f32x4 gg = *(const f32x4*)(ng + 32 * d + 8 * g + 4 * hi);
            v2u w; w.x = cvtpk(O[0][d][4 * g] * rr * gg.x, O[0][d][4 * g + 1] * rr * gg.y); w.y = cvtpk(O[0][d][4 * g + 2] * rr * gg.z, O[0][d][4 * g + 3] * rr * gg.w);
            *(v2u*)(op + 32 * d + 8 * g) = w; }
}

struct AttState { f32x16 O[2]; float m, l; };
template <class MaskFn>
__device__ __forceinline__ void block_step(AttState& st, const bf16x8 (&qf)[4], const bf16* kp, const bf16* vp0, const bf16* vp1, LAS unsigned char* vst, int lane, const MaskFn& mask) {
    const int hi = lane >> 5;
    bf16x8 kf[4];
#pragma unroll
    for (int d0 = 0; d0 < 4; ++d0) kf[d0] = *(const bf16x8*)(kp + 16 * d0);
    const v4u v00 = *(const v4u*)vp0, v01 = *(const v4u*)(vp0 + 32), v10 = *(const v4u*)vp1, v11 = *(const v4u*)(vp1 + 32);
    f32x16 s[1];
#pragma unroll
    for (int r = 0; r < 16; ++r) s[0][r] = 0.f;
#pragma unroll
    for (int d0 = 0; d0 < 4; ++d0) s[0] = MFMA32(kf[d0], qf[d0], s[0]);
#pragma unroll
    for (int r = 0; r < 16; ++r) s[0][r] = mask(r, s[0][r]);
    unsigned pw[1][8];
    softmax_update<1>(s, st.m, st.l, st.O, pw);
    *(LAS v4u*)(vst + 0 * 1024 + lane * 16) = v00; *(LAS v4u*)(vst + 1 * 1024 + lane * 16) = v10;
    *(LAS v4u*)(vst + 2 * 1024 + lane * 16) = v01; *(LAS v4u*)(vst + 3 * 1024 + lane * 16) = v11;
    LAS unsigned char* vfr = vst + ((lane >> 4) & 1) * 32 + (lane & 3) * 8 + (4 * hi + ((lane & 15) >> 2)) * 64;
#pragma unroll
    for (int ks = 0; ks < 2; ++ks)
#pragma unroll
        for (int d0 = 0; d0 < 2; ++d0) st.O[d0] = MFMA32(vfrag(vfr + (d0 * 2 + ks) * 1024), pfrag(&pw[0][4 * ks]), st.O[d0]);
}

constexpr int B_ST_O = 0, B_ST_ROW = 272, B_ST_M = 256 * 272, B_ST_L = B_ST_M + 1024, B_VST = 73728;
struct MaskB { int base; bool colok;
    __device__ __forceinline__ float operator()(int r, float s) const { const int dl = base + (r & 3) + 8 * (r >> 2); return (colok && (unsigned)(dl + 64) <= 128u) ? s : -INFINITY; } };
__device__ __forceinline__ void st_store(const AttState& st, LAS unsigned char* L, int ql, int hi, bool fin) {
    LAS float* row = (LAS float*)(L + B_ST_O + ql * B_ST_ROW);
#pragma unroll
    for (int d = 0; d < 2; ++d)
#pragma unroll
        for (int g = 0; g < 4; ++g) *(LAS f32x4*)(row + 32 * d + 8 * g + 4 * hi) = (f32x4){st.O[d][4 * g], st.O[d][4 * g + 1], st.O[d][4 * g + 2], st.O[d][4 * g + 3]};
    const float lt = st.l + xhalf(st.l);
    if (hi == 0) { ((LAS float*)(L + B_ST_M))[ql] = st.m; ((LAS float*)(L + B_ST_L))[ql] = lt; }
}
__device__ __forceinline__ void st_load(AttState& st, LAS unsigned char* L, int ql, int hi) {
    LAS float* row = (LAS float*)(L + B_ST_O + ql * B_ST_ROW);
#pragma unroll
    for (int d = 0; d < 2; ++d)
#pragma unroll
        for (int g = 0; g < 4; ++g) { const f32x4 v = *(LAS f32x4*)(row + 32 * d + 8 * g + 4 * hi); st.O[d][4 * g] = v.x; st.O[d][4 * g + 1] = v.y; st.O[d][4 * g + 2] = v.z; st.O[d][4 * g + 3] = v.w; }
    st.m = ((LAS float*)(L + B_ST_M))[ql]; st.l = hi == 0 ? ((LAS float*)(L + B_ST_L))[ql] : 0.f;
}
__device__ __forceinline__ void attn_b_unit(const bf16* QKV, bf16* Oout, int b, int h, int sp, LAS unsigned char* L, int wave, int lane) {
    const int r32 = lane & 31, hi = lane >> 5, c = r32;
    const size_t rowb = (size_t)b * SEQ; const int p0 = 256 * sp;
    const bf16* Qh = QKV + rowb * NQKV + 768 + h * 64; const bf16* Kh = QKV + rowb * NQKV + 1152 + h * 64; const bf16* Vh = QKV + rowb * NQKV + 1536 + h * 64;
    LAS unsigned char* vst = L + B_VST + wave * 4096;
    AttState st; bf16x8 qf[4];
    {   const int qpos = p0 + 32 * wave + c;
#pragma unroll
        for (int d0 = 0; d0 < 4; ++d0) qf[d0] = *(const bf16x8*)(Qh + (size_t)qpos * NQKV + 16 * d0 + 8 * hi);
        st.m = -1e30f; st.l = 0.f;
#pragma unroll
        for (int d = 0; d < 2; ++d)
#pragma unroll
            for (int r = 0; r < 16; ++r) st.O[d][r] = 0.f;
        for (int j = 0; j < 5; ++j) { const int k0 = p0 + 32 * wave - 64 + 32 * j; if (k0 < 0 || k0 >= SEQ) continue;
            MaskB mk{32 * j - 64 - c + 4 * hi, true};
            block_step(st, qf, Kh + (size_t)(k0 + r32) * NQKV + 8 * hi, Vh + (size_t)(k0 + (lane >> 2)) * NQKV + 8 * (lane & 3), Vh + (size_t)(k0 + 16 + (lane >> 2)) * NQKV + 8 * (lane & 3), vst, lane, mk); }
        st_store(st, L, 32 * wave + c, hi, false);
    }
    __syncthreads();
    {   const int rho = wave & 3, u = wave >> 2; const int ql = rho + 128 * u + 4 * c;
#pragma unroll
        for (int d0 = 0; d0 < 4; ++d0) qf[d0] = *(const bf16x8*)(Qh + (size_t)(p0 + ql) * NQKV + 16 * d0 + 8 * hi);
        st_load(st, L, ql, hi);
        const int mq0 = p0 / 4 + 32 * u;
        for (int j = 0; j < 5; ++j) { const int m0 = mq0 - 64 + 32 * j; if (m0 < 0 || m0 >= SEQ / 4) continue;
            MaskB mk{32 * j - 64 - c + 4 * hi, true};
            block_step(st, qf, Kh + (size_t)(rho + 4 * (m0 + r32)) * NQKV + 8 * hi, Vh + (size_t)(rho + 4 * (m0 + (lane >> 2))) * NQKV + 8 * (lane & 3), Vh + (size_t)(rho + 4 * (m0 + 16 + (lane >> 2))) * NQKV + 8 * (lane & 3), vst, lane, mk); }
        __syncthreads();
        st_store(st, L, ql, hi, false);
    }
    __syncthreads();
    {   const int rq = 2 * wave + (c >> 4), i = c & 15; const int ql = rq + 16 * i;
#pragma unroll
        for (int d0 = 0; d0 < 4; ++d0) qf[d0] = *(const bf16x8*)(Qh + (size_t)(p0 + ql) * NQKV + 16 * d0 + 8 * hi);
        st_load(st, L, ql, hi);
        const int mq0 = p0 / 16;
        for (int rb = 0; rb < 2; ++rb) { const int rho = 2 * wave + rb;
            for (int jb = 0; jb < 4; ++jb) { const int m0 = 32 * jb; if (m0 + 31 < mq0 - 64 || m0 > mq0 + 15 + 64) continue;
                MaskB mk{m0 - (mq0 + i) + 4 * hi, (c >> 4) == rb};
                block_step(st, qf, Kh + (size_t)(rho + 16 * (m0 + r32)) * NQKV + 8 * hi, Vh + (size_t)(rho + 16 * (m0 + (lane >> 2))) * NQKV + 8 * (lane & 3), Vh + (size_t)(rho + 16 * (m0 + 16 + (lane >> 2))) * NQKV + 8 * (lane & 3), vst, lane, mk); } }
        const float inv = 1.0f / (st.l + xhalf(st.l));
        bf16* op = Oout + (rowb + p0 + ql) * D + 256 + h * 64 + 4 * hi;
#pragma unroll
        for (int d = 0; d < 2; ++d)
#pragma unroll
            for (int g = 0; g < 4; ++g) { v2u w; w.x = cvtpk(st.O[d][4 * g] * inv, st.O[d][4 * g + 1] * inv); w.y = cvtpk(st.O[d][4 * g + 2] * inv, st.O[d][4 * g + 3] * inv); *(v2u*)(op + 32 * d + 8 * g) = w; }
    }
    __syncthreads();
}

constexpr int C_RPB = 110592;
struct MaskC1 { int cb, bb; const LAS float* rp;
    __device__ __forceinline__ float operator()(int r, float s) const { const int t = (r & 3) + 8 * (r >> 2); return ((unsigned)(cb + t) < 16u) ? s + rp[bb + t] : -INFINITY; } };
struct MaskC2 { int cb, bb; const LAS float* rp;
    __device__ __forceinline__ float operator()(int r, float s) const { const int t = (r & 3); return ((unsigned)(cb + t) < 16u) ? s + rp[bb + 31 * (r >> 2) + t] : -INFINITY; } };
__device__ __forceinline__ void attn_c_tile(const bf16* QKV, bf16* Oout, int b, int h, int grow, int half, LAS unsigned char* L, int wave, int lane) {
    const int r32 = lane & 31, hi = lane >> 5;
    const size_t rowb = (size_t)b * SEQ;
    const int c = 32 * half + r32, w0 = half ? 24 : 0;
    int rs = grow - 4; rs = rs < 0 ? 0 : (rs > 24 ? 24 : rs);
    int cs = c - 8; cs = cs < 0 ? 0 : (cs > 48 ? 48 : cs);
    const bf16* Qh = QKV + rowb * NQKV + 1920 + h * 64; const bf16* Kh = QKV + rowb * NQKV + 2304 + h * 64; const bf16* Vh = QKV + rowb * NQKV + 2688 + h * 64;
    LAS unsigned char* vst = L + B_VST + wave * 4096;
    const LAS float* rp = (const LAS float*)(L + C_RPB) + h * 15 * 31;
    AttState st; bf16x8 qf[4];
#pragma unroll
    for (int d0 = 0; d0 < 4; ++d0) qf[d0] = *(const bf16x8*)(Qh + (size_t)(grow * 64 + c) * NQKV + 16 * d0 + 8 * hi);
    st.m = -1e30f; st.l = 0.f;
#pragma unroll
    for (int d = 0; d < 2; ++d)
#pragma unroll
        for (int r = 0; r < 16; ++r) st.O[d][r] = 0.f;
    for (int j = 0; j < 8; ++j) { const int kr = rs + j; const int tok0 = kr * 64 + w0;
        MaskC1 mk{w0 + 4 * hi - cs, (kr - grow + 7) * 31 + (w0 + 4 * hi - c + 15), rp};
        block_step(st, qf, Kh + (size_t)(tok0 + r32) * NQKV + 8 * hi, Vh + (size_t)(tok0 + (lane >> 2)) * NQKV + 8 * (lane & 3), Vh + (size_t)(tok0 + 16 + (lane >> 2)) * NQKV + 8 * (lane & 3), vst, lane, mk); }
    for (int j = 0; j < 2; ++j) { const int kr0 = rs + 4 * j;
        MaskC2 mk{w0 + 32 + 4 * hi - cs, (kr0 - grow + 7) * 31 + (w0 + 32 + 4 * hi - c + 15), rp};
        const int kk = r32, k0 = lane >> 2, k1 = 16 + (lane >> 2);
        block_step(st, qf, Kh + (size_t)((kr0 + (kk >> 3)) * 64 + w0 + 32 + (kk & 7)) * NQKV + 8 * hi, Vh + (size_t)((kr0 + (k0 >> 3)) * 64 + w0 + 32 + (k0 & 7)) * NQKV + 8 * (lane & 3),
                   Vh + (size_t)((kr0 + (k1 >> 3)) * 64 + w0 + 32 + (k1 & 7)) * NQKV + 8 * (lane & 3), vst, lane, mk); }
    const float inv = 1.0f / (st.l + xhalf(st.l));
    bf16* op = Oout + (rowb + grow * 64 + c) * D + 640 + h * 64 + 4 * hi;
#pragma unroll
    for (int d = 0; d < 2; ++d)
#pragma unroll
        for (int g = 0; g < 4; ++g) { v2u w; w.x = cvtpk(st.O[d][4 * g] * inv, st.O[d][4 * g + 1] * inv); w.y = cvtpk(st.O[d][4 * g + 2] * inv, st.O[d][4 * g + 3] * inv); *(v2u*)(op + 32 * d + 8 * g) = w; }
}

__device__ __forceinline__ void attn_phase(const bf16* QKV, bf16* Oout, const float* lamp, const float* ng, const float* rpb, float lam_init, LAS unsigned char* L, int vcu, int G, int wave, int lane_in) {
    int lane = lane_in, tidx = threadIdx.x; asm volatile("" : "+v"(lane), "+v"(tidx));
    float s01 = 0.f, s23 = 0.f;
    for (int d = 0; d < 32; ++d) { s01 += lamp[d] * lamp[32 + d]; s23 += lamp[64 + d] * lamp[96 + d]; }
    const float lam = expf(s01) - expf(s23) + lam_init;
    for (int i = tidx; i < 6 * 15 * 31; i += NWAVES * 64) ((LAS float*)(L + C_RPB))[i] = rpb[i] * LOG2E;
    __syncthreads();
    for (int rep = 0; rep < REP_ATTA; ++rep) for (int u = vcu; u < BATCH * 4 * 8; u += G) attn_a_unit(QKV, Oout, u >> 5, (u >> 3) & 3, u & 7, lam, lam_init, ng, L, wave, lane);
    __syncthreads();
    for (int rep = 0; rep < REP_ATTBC; ++rep) for (int uu = vcu; uu < 768; uu += G) {
        if (uu < 384) { attn_b_unit(QKV, Oout, uu / 48, (uu / 8) % 6, uu & 7, L, wave, lane); }
        else { const int id = uu - 384; attn_c_tile(QKV, Oout, id / 48, (id / 8) % 6, 4 * (id & 7) + (wave >> 1), wave & 1, L, wave, lane); }
    }
    __syncthreads();
}
struct Args { const float* in[18]; float* out; unsigned char* ws; int ph_lo, ph_hi; };
enum { I_X = 0, I_WIN, I_WOUT, I_BETA, I_LAMBDA, I_NORMG, I_RPB, I_LN1G, I_LN1B, I_LN2G, I_LN2B, I_FG, I_FU, I_FD, I_MR, I_MG, I_MU, I_MD };
constexpr int PH_PER_LAYER = 12, PH_END = 1 + 2 * PH_PER_LAYER;

constexpr int NI_WIN = 16 * 96, NI_WOUT = 16 * 32, NI_FGU = 16 * 88, NI_FDN = 44 * 32, NI_MOE = 16 * 112;
constexpr int G_WIN = 0, G_WOUT = G_WIN + 2 * NI_WIN, G_FGU = G_WOUT + 2 * NI_WOUT, G_FDN = G_FGU + 2 * NI_FGU, G_MOE = G_FDN + NI_FDN, G_END = G_MOE + 24 * NI_MOE;
__device__ __forceinline__ void titem_decode(int g, const Args& args, unsigned char* ws, TItem& t) {
    t.ks = nullptr;
    if (g < G_WOUT) { const int l = g / NI_WIN; t.item = g % NI_WIN; t.W = args.in[I_WIN] + (size_t)l * D * NQKV; t.K = D; t.N = NQKV; t.mode = 1; t.WT = (bf16*)(ws + WS_R + R_WIN) + (size_t)l * NQKV * D; }
    else if (g < G_FGU) { const int q = g - G_WOUT, l = q / NI_WOUT; t.item = q % NI_WOUT; t.W = args.in[I_WOUT] + (size_t)l * D * D; t.K = D; t.N = D; t.mode = 0; t.WT = (bf16*)(ws + WS_R + R_WOUT) + (size_t)l * D * D; t.ks = args.in[I_BETA] + l * D; }
    else if (g < G_FDN) { const int q = g - G_FGU, u = q / NI_FGU; t.item = q % NI_FGU; t.W = args.in[u ? I_FU : I_FG]; t.K = D; t.N = DFF; t.mode = 2 + u; t.WT = (bf16*)(ws + WS_R + R_WGU); }
    else if (g < G_MOE) { t.item = g - G_FDN; t.W = args.in[I_FD]; t.K = DFF; t.N = D; t.mode = 0; t.WT = (bf16*)(ws + WS_R + R_WDN); }
    else { const int q = g - G_MOE, jb = q / NI_MOE, e = jb / 3, kind = jb % 3; t.item = q % NI_MOE;
        if (kind < 2) { t.W = args.in[kind ? I_MU : I_MG] + (size_t)e * D * DFE; t.K = D; t.N = DFE; t.mode = 2 + kind; t.WT = (bf16*)(ws + WS_WMGU) + (size_t)e * 2 * DFE * D; }
        else { t.W = args.in[I_MD] + (size_t)e * DFE * D; t.K = DFE; t.N = D; t.mode = 0; t.WT = (bf16*)(ws + WS_WMDN) + (size_t)e * D * DFE; } }
}
__device__ __forceinline__ void prologue(const Args& args, LAS unsigned char* L, int gw, int NGW, int wave, int lane) {
    unsigned char* ws = args.ws;
    LAS float* scr = (LAS float*)(L + wave * 16384);
    {   int g = gw; TItem cur, nxt; f32x4 r[8];
        if (g < G_END) { titem_decode(g, args, ws, cur); titem_load(cur, r, lane); }
        while (g < G_END) {
            titem_to_lds(cur, r, scr, lane);
            const int gn = g + NGW;
            if (gn < G_END) { titem_decode(gn, args, ws, nxt); titem_load(nxt, r, lane); }
            LDS_WAIT(); asm volatile("" ::: "memory");
            titem_store(cur, scr, lane);
            LDS_WAIT(); asm volatile("" ::: "memory");
            cur = nxt; g = gn;
        }
    }
    { const float* x = args.in[I_X]; bf16* xbf = (bf16*)(ws + WS_XBF);
      for (int m = gw; m < M; m += 2 * NGW) { const int m2 = (m + NGW < M) ? m + NGW : m;
          const GAS f32x4* xa = (const GAS f32x4*)(x + (size_t)m * D) + lane; const GAS f32x4* xb = (const GAS f32x4*)(x + (size_t)m2 * D) + lane;
          f32x4 va[4], vb[4];
#pragma unroll
          for (int j = 0; j < 4; ++j) { va[j] = xa[64 * j]; vb[j] = xb[64 * j]; }
          GAS v2u* oa = (GAS v2u*)(xbf + (size_t)m * D) + lane; GAS v2u* ob = (GAS v2u*)(xbf + (size_t)m2 * D) + lane;
#pragma unroll
          for (int j = 0; j < 4; ++j) { v2u w; w.x = pk2(va[j].x, va[j].y); w.y = pk2(va[j].z, va[j].w); oa[64 * j] = w; w.x = pk2(vb[j].x, vb[j].y); w.y = pk2(vb[j].z, vb[j].w); ob[64 * j] = w; } } }
    { float* ta = (float*)(ws + WS_TAB + T_ROPEA); float* tb = (float*)(ws + WS_TAB + T_ROPEB);
      for (int i = gw * 64 + lane; i < SEQ * 8; i += NGW * 64) {
          const int p = i >> 3, j = i & 7; const float invb = powf(ROPE_THETA, -(float)(2 * j) / 16.0f); const float angb = (float)p * invb;
          tb[p * 16 + j] = (float)cos((double)angb); tb[p * 16 + 8 + j] = (float)sin((double)angb);
          if (j < 4) { const float inva = powf(ROPE_THETA, -(float)(2 * j) / 8.0f); const float anga = (float)p * inva; ta[p * 8 + j] = (float)cos((double)anga); ta[p * 8 + 4 + j] = (float)sin((double)anga); } } }
}

__global__ void __launch_bounds__(NWAVES * 64, 2) mega(Args args) {
    extern __shared__ __attribute__((aligned(16))) unsigned char lds[];
    LAS unsigned char* L = (LAS unsigned char*)lds;
    volatile LAS unsigned* MISC = (volatile LAS unsigned*)(L + MISC_OFF);
    const int tid = threadIdx.x, lane = tid & 63, wave = __builtin_amdgcn_readfirstlane(tid >> 6);
    const int G = gridDim.x; const int bx = blockIdx.x;
    const int vcu = (G % 8 == 0) ? (bx % 8) * (G / 8) + bx / 8 : bx;
    const int gw = vcu * NWAVES + wave, NGW = G * NWAVES;
    unsigned char* ws = args.ws;
    gu32* ctl = (gu32*)(ws + WS_CTL);
    for (int u = tid; u < (LDS_BYTES - RING_BYTES) / 4; u += NWAVES * 64) ((LAS unsigned*)(L + RING_BYTES))[u] = 0u;
    __syncthreads();
    const int lo = args.ph_lo, hi = args.ph_hi;
    XcdBarrier bar; bar.bar = (unsigned*)(ctl + CW_BAR); bar.x = 0; bar.st = nullptr;
    if (hi - lo > 1) bar = xcd_barrier_post((unsigned*)(ctl + CW_BAR), MISC + 8);
#define IN(k) (lo <= (k) && (k) < hi)
#if PROBE_STAMP >= 0
    unsigned long long tst_prev = __builtin_amdgcn_s_memrealtime(), tsel = 0ull; int pidx = 0;
#define SEAM(nextk) do { if ((nextk) < hi) xcd_barrier(bar); { const unsigned long long now_ = __builtin_amdgcn_s_memrealtime(); if (pidx == PROBE_STAMP) tsel = now_ - tst_prev; tst_prev = now_; ++pidx; } } while (0)
#else
#define SEAM(nextk) do { if ((nextk) < hi) xcd_barrier(bar); } while (0)
#endif
    bf16* XBF = (bf16*)(ws + WS_XBF);
    unsigned char* R = ws + WS_R;
    const float* ropeA = (const float*)(ws + WS_TAB + T_ROPEA); const float* ropeB = (const float*)(ws + WS_TAB + T_ROPEB);

    if (IN(0)) { _Pragma("unroll") for (int rep = 0; rep < REP_PRO; ++rep) prologue(args, L, gw, NGW, wave, lane); SEAM(1); }

    for (int l = 0; l < DEPTH; ++l) {
        const int pb = 1 + PH_PER_LAYER * l;
        if (hi <= pb || lo >= pb + PH_PER_LAYER) continue;
        if (IN(pb + 0)) {
            pg8::Gemm g{XBF, (const bf16*)(R + R_WIN) + (size_t)l * NQKV * D, M, NQKV, D}; pg8::StaticOrder S; S.init(M, NQKV, G, bx);
            pg8::EpiQKV E{(bf16*)(R + R_QKV), ropeA, ropeB};
            _Pragma("unroll") for (int rep = 0; rep < REP_DENSE; ++rep) pg8::gemm_phase<pg8::EpiQKV, pg8::StaticOrder, true, true>(L, g, S, E);
            SEAM(pb + 1);
        }
        if (IN(pb + 1)) {
            attn_phase((const bf16*)(R + R_QKV), (bf16*)(R + R_O), args.in[I_LAMBDA] + l * 128, args.in[I_NORMG] + l * 64, args.in[I_RPB] + (size_t)l * 6 * 15 * 31,
                       0.8f - 0.6f * expf(-0.3f * (float)l), L, vcu, G, wave, lane);
            SEAM(pb + 2);
        }

        if (IN(pb + 2)) {
            pg8::Gemm g{(const bf16*)(R + R_O), (const bf16*)(R + R_WOUT) + (size_t)l * D * D, M, D, D}; pg8::StaticOrder S; S.init(M, D, G, bx);
            pg8::EpiStoreBf16 E{(bf16*)(R + R_MIX), D, 0, 1 << 20};
            _Pragma("unroll") for (int rep = 0; rep < REP_DENSE; ++rep) pg8::gemm_phase<pg8::EpiStoreBf16, pg8::StaticOrder, true, true>(L, g, S, E);
            SEAM(pb + 3);
        }
        if (IN(pb + 3)) {

            if (l == 0) ln_phase<0, false, false, false, true>(args.in[I_X], (const bf16*)(R + R_MIX), nullptr, nullptr, args.in[I_LN1G] + l * D, args.in[I_LN1B] + l * D, args.out, XBF, nullptr, nullptr, nullptr, nullptr, nullptr, L, gw, NGW, lane);
            else ln_phase<0, true, true, false, true>(XBF, (const bf16*)(R + R_MIX), nullptr, nullptr, args.in[I_LN1G] + l * D, args.in[I_LN1B] + l * D, args.out, XBF, args.in[I_MR] + (size_t)(l / 2) * D * NEXP, ctl + CW_CNT,
                                         (int*)(ws + WS_TAB + T_TOKE), (int*)(ws + WS_TAB + T_TOKS), (float*)(ws + WS_TAB + T_TOKG), L, gw, NGW, lane);
            SEAM(pb + 4);
        }

        if ((l & 1) == 0) {
            if (IN(pb + 4)) {
                pg8::Gemm g{XBF, (const bf16*)(R + R_WGU), M, 2 * DFF, D}; pg8::StaticOrder S; S.init(M, 2 * DFF, G, bx);
                pg8::EpiSwiglu E{(bf16*)(R + R_H), DFF, 0, 1 << 20};
                _Pragma("unroll") for (int rep = 0; rep < REP_DENSE; ++rep) pg8::gemm_phase<pg8::EpiSwiglu, pg8::StaticOrder, true, true>(L, g, S, E);
                SEAM(pb + 5);
            }
            if (IN(pb + 5)) {
                pg8::Gemm g{(const bf16*)(R + R_H), (const bf16*)(R + R_WDN), M, D, DFF}; pg8::StaticOrder S; S.init(M, D, G, bx);
                pg8::EpiStoreBf16 E{(bf16*)(R + R_F), D, 0, 1 << 20};
                _Pragma("unroll") for (int rep = 0; rep < REP_DENSE; ++rep) pg8::gemm_phase<pg8::EpiStoreBf16, pg8::StaticOrder, true, true>(L, g, S, E);
                SEAM(pb + 9);
            }
        } else {
            const bf16* WMGU = (const bf16*)(ws + WS_WMGU) + (size_t)(l / 2) * NEXP * 2 * DFE * D; const bf16* WMDN = (const bf16*)(ws + WS_WMDN) + (size_t)(l / 2) * NEXP * D * DFE;
            int* tile_e = (int*)(ws + WS_TAB + T_TILEE);
            if (IN(pb + 4)) {
                moe_gather(ctl + CW_CNT, (const int*)(ws + WS_TAB + T_TOKE), (int*)(ws + WS_TAB + T_TOKS), XBF, (bf16*)(R + R_XS), tile_e, L, gw, NGW, lane);
                SEAM(pb + 5);
            }
            for (int p = 0; p < 2; ++p) {
                if (!(IN(pb + 5 + 2 * p) || IN(pb + 6 + 2 * p))) continue;
                const int nt_all = __builtin_amdgcn_readfirstlane(tile_e[TMAX]);
                const int tile0 = p * PASS0_TILES; int nt = nt_all - tile0; nt = nt < 0 ? 0 : (nt > (p == 0 ? PASS0_TILES : HMOE_TILES) ? (p == 0 ? PASS0_TILES : HMOE_TILES) : nt);
                if (IN(pb + 5 + 2 * p)) {
                    pg8::Gemm g{(const bf16*)(R + R_XS), WMGU, 0, 0, D}; pg8::GroupedOrder S{nt, tile0, 2 * DFE / 256, G, bx, 0, tile_e};
                    pg8::EpiSwiglu E{(bf16*)(R + R_HM), DFE, -tile0, 2 * DFE / 256};
                    _Pragma("unroll") for (int rep = 0; rep < REP_MOEGU; ++rep) pg8::gemm_phase<pg8::EpiSwiglu, pg8::GroupedOrder, true, true>(L, g, S, E);
                    SEAM(pb + 6 + 2 * p);
                }
                if (IN(pb + 6 + 2 * p)) {
                    pg8::Gemm g{(const bf16*)(R + R_HM), WMDN, 0, 0, DFE}; pg8::GroupedOrder S{nt, tile0, D / 256, G, bx, 1, tile_e};
                    pg8::EpiStoreBf16 E{(bf16*)(R + R_XS), D, tile0, D / 256};
                    _Pragma("unroll") for (int rep = 0; rep < REP_MOEDN; ++rep) pg8::gemm_phase<pg8::EpiStoreBf16, pg8::GroupedOrder, true, true>(L, g, S, E);
                    SEAM(pb + 7 + 2 * p);
                }
            }

        }
        if (IN(pb + 9)) {
            if ((l & 1) == 0) ln_phase<0, false, true, false, true>(XBF, (const bf16*)(R + R_F), nullptr, nullptr, args.in[I_LN2G] + l * D, args.in[I_LN2B] + l * D, args.out, XBF, nullptr, nullptr, nullptr, nullptr, nullptr, L, gw, NGW, lane);
            else ln_phase<1, false, true, true, false>(XBF, (const bf16*)(R + R_XS), (const int*)(ws + WS_TAB + T_TOKS), (const float*)(ws + WS_TAB + T_TOKG), args.in[I_LN2G] + l * D, args.in[I_LN2B] + l * D, args.out, XBF,
                                           nullptr, nullptr, nullptr, nullptr, nullptr, L, gw, NGW, lane);
            SEAM(pb + PH_PER_LAYER);
        }

    }
#if PROBE_STAMP >= 0
    if (blockIdx.x == 0 && tid == 0) { const unsigned long long t0_ = __builtin_amdgcn_s_memrealtime(); while (__builtin_amdgcn_s_memrealtime() - t0_ < tsel) __builtin_amdgcn_s_sleep(8); }
#endif
#undef IN
#undef SEAM
}
}
extern "C" void kernel_launch(void* const* d_in, const int* in_sizes, int n_in, void* d_out, int out_size, void* d_ws, size_t ws_size, hipStream_t stream) {
    using namespace mk;
    static int grid = 0;
    if (grid == 0) {
        int dev = 0, cus = 0, per_cu = 0;
        if (n_in != 18 || out_size != M * D || ws_size < WS_END) { fprintf(stderr, "kernel_launch: unexpected problem (n_in %d, out %d, ws %zu < %zu)\n", n_in, out_size, ws_size, (size_t)WS_END); grid = -1; return; }
        if (hipGetDevice(&dev) != hipSuccess || hipDeviceGetAttribute(&cus, hipDeviceAttributeMultiprocessorCount, dev) != hipSuccess) { grid = -1; return; }
        if (hipFuncSetAttribute((const void*)mega, hipFuncAttributeMaxDynamicSharedMemorySize, LDS_BYTES) != hipSuccess) { fprintf(stderr, "kernel_launch: hipFuncSetAttribute failed\n"); grid = -1; return; }
        if (hipOccupancyMaxActiveBlocksPerMultiprocessor(&per_cu, (const void*)mega, NWAVES * 64, LDS_BYTES) != hipSuccess || per_cu < 1) { fprintf(stderr, "kernel_launch: occupancy query reports %d workgroups per CU\n", per_cu); }
        (void)hipGetLastError();
        grid = cus;
    }
    if (grid < 0) return;
    unsigned char* ws = (unsigned char*)d_ws;
    (void)hipMemsetAsync(ws + WS_CTL, 0, CTL_ZERO_BYTES, stream);
    Args a{};
    for (int i = 0; i < 18; ++i) a.in[i] = (const float*)d_in[i];
    a.out = (float*)d_out; a.ws = ws; a.ph_lo = 0; a.ph_hi = PH_END;
    hipLaunchKernelGGL(mega, dim3(grid), dim3(NWAVES * 64), LDS_BYTES, stream, a);
}
```
